# Optimizing an MI355X kernel written in HIP

```python
import math
import jax, jax.numpy as jnp
from jax import lax
import numpy as np

D_MODEL = 1024
BATCH = 4
SEQ = 8192
DEPTH = 4

N_META = 16
POOL_WIDTH = D_MODEL // 2
POOL_WINDOWS = (2, 4, 8, 16)
POOL_GROUPS = len(POOL_WINDOWS)
POOL_GROUP_DIM = POOL_WIDTH // POOL_GROUPS
N_HEADS = 8
QK_NOPE_DIM = 64
QK_ROPE_DIM = 32
QK_HEAD_DIM = QK_NOPE_DIM + QK_ROPE_DIM
V_HEAD_DIM = 64
MLA_WIDTH = N_HEADS * V_HEAD_DIM
KV_LORA_RANK = 256
Q_LORA_RANK = 768
ROPE_THETA = 10000.0
NORM_EPS = 1e-6
Q_BLOCK = 128
MASK_VALUE = -1e30

IN_SPLITS = (POOL_WIDTH, POOL_WIDTH, Q_LORA_RANK, KV_LORA_RANK, QK_ROPE_DIM, MLA_WIDTH, D_MODEL, D_MODEL)
D_IN = sum(IN_SPLITS)
IN_SPLIT_POINTS = tuple(int(v) for v in np.cumsum(IN_SPLITS)[:-1])

kernel_name = "hybrid_pool_mla_gated_trunk"


def rmsnorm(x, gain):
    xf = x.astype(jnp.float32)
    inv = lax.rsqrt(jnp.mean(xf * xf, axis=-1, keepdims=True) + NORM_EPS)
    return (xf * inv * gain.astype(jnp.float32)).astype(x.dtype)


def apply_rope(x, pos):
    half = x.shape[-1] // 2
    inv_freq = ROPE_THETA ** (-jnp.arange(half, dtype=jnp.float32) / half)
    ang = pos.astype(jnp.float32)[..., None] * inv_freq
    cos = jnp.cos(ang)[:, :, None, :]
    sin = jnp.sin(ang)[:, :, None, :]
    xf = x.astype(jnp.float32)
    x1, x2 = xf[..., :half], xf[..., half:]
    return jnp.concatenate([x1 * cos - x2 * sin, x2 * cos + x1 * sin], axis=-1).astype(x.dtype)


def pool_mix(u, w_group, scale):
    B, L, _ = u.shape
    ug = u.reshape(B, L, POOL_GROUPS, POOL_GROUP_DIM).astype(jnp.float32)
    csum = jnp.cumsum(ug, axis=1)
    t1 = jnp.arange(1, L + 1, dtype=jnp.float32)
    means = []
    for g, w in enumerate(POOL_WINDOWS):
        s = csum[:, :, g]
        lag = jnp.pad(s, ((0, 0), (w, 0), (0, 0)))[:, :L]
        cnt = jnp.minimum(t1, float(w))[None, :, None]
        means.append((s - lag) / cnt)
    mixed = (jnp.stack(means, axis=2) - ug).astype(u.dtype)
    y = jnp.einsum('blgc,gcd->blgd', mixed, w_group)
    return y.reshape(B, L, POOL_WIDTH) * scale


def causal_block_attention(q, k, v):
    B, L = q.shape[0], q.shape[1]
    pad_front = (-N_META) % Q_BLOCK
    pad_back = (-(L + pad_front)) % Q_BLOCK
    padw = ((0, 0), (pad_front, pad_back), (0, 0), (0, 0))
    q, k, v = jnp.pad(q, padw), jnp.pad(k, padw), jnp.pad(v, padw)
    n_blocks = q.shape[1] // Q_BLOCK
    scale = 1.0 / math.sqrt(QK_HEAD_DIM)
    outs = []
    for i in range(n_blocks):
        q0 = i * Q_BLOCK
        kend = q0 + Q_BLOCK
        s = jnp.einsum('bqhd,bkhd->bhqk', q[:, q0:kend], k[:, :kend]).astype(jnp.float32) * scale
        qi = jnp.arange(q0, kend)[:, None]
        ki = jnp.arange(kend)[None, :]
        valid = (ki <= qi) & (ki >= pad_front)
        s = jnp.where(valid, s, MASK_VALUE)
        p = jax.nn.softmax(s, axis=-1).astype(v.dtype)
        outs.append(jnp.einsum('bhqk,bkhd->bqhd', p, v[:, :kend]))
    o = jnp.concatenate(outs, axis=1)
    return o[:, pad_front:pad_front + L]


def mla(c_q_raw, c_kv_raw, k_rope_raw, pos, g_qa, g_kva, w_q_b, w_kv_b, g_qn, g_kn):
    B, L, _ = c_q_raw.shape
    c_q = rmsnorm(c_q_raw, g_qa)
    c_kv = rmsnorm(c_kv_raw, g_kva)
    q = (c_q @ w_q_b).reshape(B, L, N_HEADS, QK_HEAD_DIM)
    kv = (c_kv @ w_kv_b).reshape(B, L, N_HEADS, QK_NOPE_DIM + V_HEAD_DIM)
    k_nope, v = kv[..., :QK_NOPE_DIM], kv[..., QK_NOPE_DIM:]
    k_pe = jnp.broadcast_to(k_rope_raw[:, :, None, :], (B, L, N_HEADS, QK_ROPE_DIM))
    k = jnp.concatenate([k_nope, k_pe], axis=-1)
    q = rmsnorm(q, g_qn)
    k = rmsnorm(k, g_kn)
    q = jnp.concatenate([q[..., :QK_NOPE_DIM], apply_rope(q[..., QK_NOPE_DIM:], pos)], axis=-1)
    k = jnp.concatenate([k[..., :QK_NOPE_DIM], apply_rope(k[..., QK_NOPE_DIM:], pos)], axis=-1)
    o = causal_block_attention(q, k, v)
    return o.reshape(B, L, MLA_WIDTH)


def setup_inputs(seed: int = 0) -> dict:
    key = jax.random.key(seed)
    ks = jax.random.split(key, 18)
    f32 = jnp.float32

    def nrm(k, shape, scale):
        return jax.random.normal(k, shape, f32) * scale

    def gain(k, shape):
        return 1.0 + 0.02 * jax.random.normal(k, shape, f32)

    x = jax.random.normal(ks[0], (BATCH, SEQ, D_MODEL), f32)
    offset = jax.random.randint(ks[1], (BATCH, 1), 0, 4096, dtype=jnp.int32)
    positions = offset + jnp.arange(SEQ, dtype=jnp.int32)[None, :]
    return {
        "x": x,
        "positions": positions,
        "meta_tokens": nrm(ks[2], (N_META, D_MODEL), 1.0),
        "norm_gain": gain(ks[3], (DEPTH, D_MODEL)),
        "w_in": nrm(ks[4], (DEPTH, D_MODEL, D_IN), D_MODEL ** -0.5),
        "pool_w_group": nrm(ks[5], (DEPTH, POOL_GROUPS, POOL_GROUP_DIM, POOL_GROUP_DIM), POOL_GROUP_DIM ** -0.5),
        "pool_scale": gain(ks[6], (DEPTH, POOL_WIDTH)),
        "pool_w_up": nrm(ks[7], (DEPTH, POOL_WIDTH, D_MODEL), POOL_WIDTH ** -0.5),
        "q_a_norm_gain": gain(ks[8], (DEPTH, Q_LORA_RANK)),
        "kv_a_norm_gain": gain(ks[9], (DEPTH, KV_LORA_RANK)),
        "w_q_b": nrm(ks[10], (DEPTH, Q_LORA_RANK, N_HEADS * QK_HEAD_DIM), Q_LORA_RANK ** -0.5),
        "w_kv_b": nrm(ks[11], (DEPTH, KV_LORA_RANK, N_HEADS * (QK_NOPE_DIM + V_HEAD_DIM)), KV_LORA_RANK ** -0.5),
        "q_norm_gain": gain(ks[12], (DEPTH, QK_HEAD_DIM)),
        "k_norm_gain": gain(ks[13], (DEPTH, QK_HEAD_DIM)),
        "mla_w_up": nrm(ks[14], (DEPTH, MLA_WIDTH, D_MODEL), MLA_WIDTH ** -0.5),
        "w_out": nrm(ks[15], (DEPTH, D_MODEL, D_MODEL), (D_MODEL * 2 * DEPTH) ** -0.5),
    }


def reference(x, positions, meta_tokens, norm_gain, w_in, pool_w_group, pool_scale, pool_w_up,
              q_a_norm_gain, kv_a_norm_gain, w_q_b, w_kv_b, q_norm_gain, k_norm_gain, mla_w_up, w_out):
    B = x.shape[0]
    meta = jnp.broadcast_to(meta_tokens[None].astype(x.dtype), (B, N_META, D_MODEL))
    h_res = jnp.concatenate([meta, x], axis=1)
    meta_pos = jnp.broadcast_to(jnp.arange(N_META, dtype=jnp.int32)[None], (B, N_META))
    pos = jnp.concatenate([meta_pos, positions + N_META], axis=1)

    for l in range(DEPTH):
        h = rmsnorm(h_res, norm_gain[l])
        proj = h @ w_in[l]
        u_pool, z_pool, c_q, c_kv, k_rope, z_mla, g_pool, g_mla = jnp.split(proj, IN_SPLIT_POINTS, axis=-1)
        y_pool = (pool_mix(u_pool, pool_w_group[l], pool_scale[l]) * jax.nn.silu(z_pool)) @ pool_w_up[l]
        o_mla = mla(c_q, c_kv, k_rope, pos, q_a_norm_gain[l], kv_a_norm_gain[l], w_q_b[l], w_kv_b[l],
                    q_norm_gain[l], k_norm_gain[l])
        y_mla = (o_mla * jax.nn.silu(z_mla)) @ mla_w_up[l]
        merged = jax.nn.sigmoid(g_pool) * y_pool + jax.nn.sigmoid(g_mla) * y_mla
        h_res = h_res + merged @ w_out[l]

    return h_res[:, N_META:]
```

```cpp
#include <hip/hip_runtime.h>
#include <hip/hip_cooperative_groups.h>
#include <cstdio>
#include <cstdint>
namespace cg = cooperative_groups;

#ifndef PHM
#define PHM 511
#endif
#ifndef PHM2
#define PHM2 7
#endif
#ifndef MK_COOP
#define MK_COOP 0
#endif

#define LAS __attribute__((address_space(3)))
typedef unsigned short bf16_t;
typedef short bf16x8 __attribute__((ext_vector_type(8)));
typedef float f32x4 __attribute__((ext_vector_type(4)));
typedef float f32x16 __attribute__((ext_vector_type(16)));
typedef unsigned u32x4 __attribute__((ext_vector_type(4)));
typedef unsigned u32x2 __attribute__((ext_vector_type(2)));

constexpr int BATCH = 4, SEQ = 8192, DM = 1024, DEPTH = 4, NMETA = 16;
constexpr int PADF = 112, LP = 8320, MP = BATCH * LP;
constexpr int NH = 8;
constexpr int DIN = 4640;
constexpr float EPS = 1e-6f;
constexpr int PW = 4608;
constexpr int C_U = 0, C_Z = 512, C_CQ = 1024, C_CKV = 1792, C_ZM = 2048, C_GP = 2560, C_GM = 3584;
constexpr int C_P1Y = 0, C_MPOOL = 512, C_OZ = 1536;
constexpr int NIN_PAD = 4864;

constexpr size_t MiB = 1u << 20;
constexpr size_t WS_W = 1 * MiB;
constexpr size_t W_IN = 0, W_Q = W_IN + (size_t)NIN_PAD * 1024 * 2, W_KV = W_Q + 768 * 768 * 2, W_G = W_KV + 1024 * 256 * 2,
                 W_PU = W_G + 512 * 256 * 2, W_MU = W_PU + 1024 * 512 * 2, W_O = W_MU + 1024 * 512 * 2, W_END = W_O + 1024 * 1024 * 2;
static_assert(W_END <= 16 * MiB, "weights");
constexpr size_t WS_ROPE = 17 * MiB, WS_METAH = 22 * MiB, WS_KROPE = 23 * MiB, WS_H = 26 * MiB, WS_PROJ = 91 * MiB, WS_QRAW = 384 * MiB, WS_KVRAW = 433 * MiB, WS_END = 498 * MiB;
static_assert(WS_H + (size_t)MP * 1024 * 2 <= WS_PROJ && WS_PROJ + (size_t)MP * PW * 2 <= WS_QRAW && WS_QRAW + (size_t)MP * 768 * 2 <= WS_KVRAW && WS_KVRAW + (size_t)MP * 1024 * 2 <= WS_END, "ws map");

constexpr int LDS_BYTES = 147456;

struct Args {
    const float* x; const int* pos; const float* meta; const float* norm_gain; const float* w_in; const float* pool_wg; const float* pool_scale; const float* pool_wu;
    const float* qa_gain; const float* kva_gain; const float* w_qb; const float* w_kvb; const float* qn_gain; const float* kn_gain; const float* mla_wu; const float* w_out;
    float* out; unsigned char* ws; int ph_lo, ph_hi;
};

__device__ __forceinline__ unsigned cvt_pk_bf16(float lo, float hi) { unsigned r; asm volatile("v_cvt_pk_bf16_f32 %0, %1, %2" : "=v"(r) : "v"(lo), "v"(hi)); return r; }
__device__ __forceinline__ float bf_lo(unsigned u) { return __uint_as_float(u << 16); }
__device__ __forceinline__ float bf_hi(unsigned u) { return __uint_as_float(u & 0xffff0000u); }
__device__ __forceinline__ float wave_sum(float v) {
#pragma unroll
    for (int o = 1; o < 64; o <<= 1) v += __shfl_xor(v, o);
    return v;
}
__device__ __forceinline__ float sigmoidf_(float g) { return __builtin_amdgcn_rcpf(1.f + __expf(-g)); }
__device__ __forceinline__ float siluf_(float z) { return z * sigmoidf_(z); }
#define LDS_WAIT() asm volatile("s_waitcnt lgkmcnt(0)" ::: "memory")
__device__ __forceinline__ int opaque_tid() { int t = threadIdx.x; asm volatile("" : "+v"(t)); return t; }

namespace pg8 {
constexpr int BM = 256, BK = 64, HALF = 128, HTB = HALF * BK * 2, STAGE_BYTES = 8 * HTB, NXCD = 8, WGM = 8;
__host__ __device__ __forceinline__ int lds_byte(int r, int c) { const int st = (r >> 4) * 2 + (c >> 5), rr = r & 15, cc = c & 31, ob = rr * 64 + cc * 2; return st * 1024 + (ob ^ (((ob >> 9) & 1) << 5)); }
__host__ __device__ __forceinline__ void stage_rc(int b, int& R, int& C) { const int st = b / 1024, sb = b % 1024, swz = sb ^ (((sb >> 9) & 1) << 5); R = (st >> 1) * 16 + swz / 64; C = (st & 1) * 32 + (swz % 64) / 2; }
__host__ __device__ __forceinline__ int perm32(int rho) { const int n = rho >> 4, i = rho & 15; return 8 * (i >> 2) + 4 * n + (i & 3); }
struct Unit { int pm, pn; };
struct Gemm { const bf16_t* A; int lda; const bf16_t* Bt; int ldb; int M, N, K; int apn; };
struct StaticOrder {
    int nM, nN, nwg, G, c;
    __device__ void init(int M, int N, int G_, int c_) { nM = M / BM; nN = N / BM; nwg = nM * nN; G = G_; c = c_; }
    __device__ bool next(int i, Unit& u) const {
        const long L = (long)i * G + c; if (L >= nwg) return false;
        int wgid = (int)L; { const int q = nwg / NXCD, r = nwg % NXCD, xcd = wgid % NXCD, off = wgid / NXCD; wgid = (xcd < r ? xcd * (q + 1) : r * (q + 1) + (xcd - r) * q) + off; }
        const int nig = WGM * nN, gid = wgid / nig, fm = gid * WGM, gsz = (nM - fm) < WGM ? (nM - fm) : WGM;
        u.pm = fm + ((wgid % nig) % gsz); u.pn = (wgid % nig) / gsz; return true;
    }
};
template <class F> struct Epi {
    F f;
    __device__ __forceinline__ void operator()(const f32x4 (&acc)[2][2][4][2], const Unit& u, int wr, int wc, int fr, int fq) const {
#pragma unroll
        for (int ai = 0; ai < 2; ++ai)
#pragma unroll
            for (int m = 0; m < 4; ++m) {
                const int row = u.pm * BM + ai * HALF + wr * 64 + m * 16 + fr;
#pragma unroll
                for (int bj = 0; bj < 2; ++bj) f(row, u.pn * BM + bj * HALF + wc * 32 + 8 * fq, u.pn, acc[ai][bj][m][0], acc[ai][bj][m][1]);
                asm volatile("" ::: "memory");
            }
    }
};

template <class EpiT>
__device__ __forceinline__ void gemm_phase(LAS unsigned char* lds, const Gemm g, const StaticOrder& S, const EpiT& E) {
    const int tid = opaque_tid(), wid = __builtin_amdgcn_readfirstlane(tid >> 6), lane = tid & 63, wr = wid >> 2, wc = wid & 3, fr = lane & 15, fq = lane >> 4;
    int K = g.K; asm volatile("" : "+s"(K)); const int nt = K / BK;
    unsigned voffA[2], voffB[2];
#pragma unroll
    for (int i = 0; i < 2; ++i) { int R, C; stage_rc(tid * 16 + i * 8192, R, C); const int Rb = (R & ~31) + perm32(R & 31);
        voffA[i] = (unsigned)(R * g.lda + C) * 2u; voffB[i] = (unsigned)(Rb * g.ldb + C) * 2u; }
    const size_t kstep = (size_t)(BK * 2);
    const size_t hA = (size_t)HALF * g.lda * 2, hB = (size_t)HALF * g.ldb * 2;
    const size_t tA = 2 * hA, tB = 2 * hB;
    const unsigned ldsw = (unsigned)wid * 1024u;
    const int aoff = lds_byte(wr * 64 + fr, fq * 8), boff = lds_byte(wc * 32 + fr, fq * 8);
#define PG8_SA(b, h) (((b) * 2 + (h)) * HTB)
#define PG8_SB(b, h) ((4 + (b) * 2 + (h)) * HTB)
#define PG8_STAGE(bufoff, gbase, voff) do { _Pragma("unroll") for (int _i = 0; _i < 2; ++_i) \
        __builtin_amdgcn_global_load_lds((const unsigned*)((const char*)(gbase) + (voff)[_i]), (LAS unsigned*)(lds + (bufoff) + ldsw + _i * 8192), 16, 0, 0); } while (0)
#define PG8_LDA(dst, b, h) do { _Pragma("unroll") for (int m = 0; m < 4; ++m) _Pragma("unroll") for (int k = 0; k < 2; ++k) dst[m][k] = *(const LAS bf16x8*)(lds + PG8_SA(b, h) + aoff + m * 2048 + k * 1024); } while (0)
#define PG8_LDB(dst, b, h) do { _Pragma("unroll") for (int n = 0; n < 2; ++n) _Pragma("unroll") for (int k = 0; k < 2; ++k) dst[n][k] = *(const LAS bf16x8*)(lds + PG8_SB(b, h) + boff + n * 2048 + k * 1024); } while (0)
#define PG8_MMA(ai, bj, At, Bt) do { __builtin_amdgcn_s_setprio(1); _Pragma("unroll") for (int m = 0; m < 4; ++m) _Pragma("unroll") for (int n = 0; n < 2; ++n) _Pragma("unroll") for (int k = 0; k < 2; ++k) \
        acc[ai][bj][m][n] = __builtin_amdgcn_mfma_f32_16x16x32_bf16(Bt[n][k], At[m][k], acc[ai][bj][m][n], 0, 0, 0); __builtin_amdgcn_s_setprio(0); } while (0)
#define PG8_WAIT_V(n) asm volatile("s_waitcnt vmcnt(" #n ")" ::: "memory")
#define PG8_WAIT_L(n) asm volatile("s_waitcnt lgkmcnt(" #n ")" ::: "memory")
#define PG8_BAR __builtin_amdgcn_s_barrier()
#define PG8_SCHED __builtin_amdgcn_sched_barrier(0)
    Unit cur, nxt; int ui = 0;
    if (!S.next(0, cur)) return;
    f32x4 acc[2][2][4][2];
#pragma unroll
    for (int a = 0; a < 2; ++a)
#pragma unroll
        for (int b = 0; b < 2; ++b)
#pragma unroll
            for (int m = 0; m < 4; ++m)
#pragma unroll
                for (int n = 0; n < 2; ++n) acc[a][b][m][n] = (f32x4){0.f, 0.f, 0.f, 0.f};
    bf16x8 At[4][2], B0[2][2], B1[2][2];
    const char* cA = (const char*)g.A + (size_t)cur.pm * tA + (size_t)cur.pn * g.apn * 2; const char* cB = (const char*)g.Bt + (size_t)cur.pn * tB;
    PG8_STAGE(PG8_SB(0, 0), cB, voffB); PG8_STAGE(PG8_SB(0, 1), cB + hB, voffB); PG8_STAGE(PG8_SA(0, 0), cA, voffA); PG8_STAGE(PG8_SA(0, 1), cA + hA, voffA);
    if (wr == 1) PG8_BAR;
    PG8_WAIT_V(2); PG8_BAR;
    PG8_STAGE(PG8_SB(1, 0), cB + kstep, voffB); PG8_STAGE(PG8_SA(1, 0), cA + kstep, voffA); PG8_STAGE(PG8_SB(1, 1), cB + hB + kstep, voffB);
    PG8_WAIT_V(6); PG8_BAR;
    for (;;) {
        const bool has_next = S.next(ui + 1, nxt);
        const char* nA = has_next ? (const char*)g.A + (size_t)nxt.pm * tA + (size_t)nxt.pn * g.apn * 2 : cA; const char* nB = has_next ? (const char*)g.Bt + (size_t)nxt.pn * tB : cB;
#pragma unroll 1
        for (int t = 0; t < nt; t += 2) {
            const bool last = (t == nt - 2);
            const char* a1 = cA + (size_t)(t + 1) * kstep;
            const char* a2 = last ? nA : cA + (size_t)(t + 2) * kstep; const char* b2 = last ? nB : cB + (size_t)(t + 2) * kstep;
            const char* a3 = a2 + kstep; const char* b3 = b2 + kstep;
            PG8_LDB(B0, 0, 0); PG8_LDB(B1, 0, 1); PG8_SCHED; PG8_LDA(At, 0, 0); PG8_STAGE(PG8_SA(1, 1), a1 + hA, voffA);
            PG8_WAIT_V(8); PG8_WAIT_L(0); PG8_BAR; PG8_MMA(0, 0, At, B0); PG8_MMA(0, 1, At, B1); PG8_BAR; PG8_SCHED;
            PG8_LDA(At, 0, 1); PG8_STAGE(PG8_SB(0, 0), b2, voffB); PG8_STAGE(PG8_SB(0, 1), b2 + hB, voffB); PG8_STAGE(PG8_SA(0, 0), a2, voffA);
            PG8_WAIT_V(8); PG8_WAIT_L(0); PG8_BAR; PG8_MMA(1, 0, At, B0); PG8_MMA(1, 1, At, B1); PG8_BAR; PG8_SCHED;
            PG8_LDB(B0, 1, 0); PG8_LDB(B1, 1, 1); PG8_SCHED; PG8_LDA(At, 1, 0); PG8_STAGE(PG8_SA(0, 1), a2 + hA, voffA);
            PG8_WAIT_V(8); PG8_WAIT_L(0); PG8_BAR; PG8_MMA(0, 0, At, B0); PG8_MMA(0, 1, At, B1); PG8_BAR; PG8_SCHED;
            PG8_LDA(At, 1, 1); PG8_STAGE(PG8_SB(1, 0), b3, voffB); PG8_STAGE(PG8_SB(1, 1), b3 + hB, voffB); PG8_STAGE(PG8_SA(1, 0), a3, voffA);
            PG8_WAIT_V(8); PG8_WAIT_L(0); PG8_BAR; PG8_MMA(1, 0, At, B0); PG8_MMA(1, 1, At, B1); PG8_BAR; PG8_SCHED;
        }
        if (wr == 0) PG8_BAR;
        E(acc, cur, wr, wc, fr, fq);
        if (!has_next) break;
#pragma unroll
        for (int a = 0; a < 2; ++a)
#pragma unroll
            for (int b = 0; b < 2; ++b)
#pragma unroll
                for (int m = 0; m < 4; ++m)
#pragma unroll
                    for (int n = 0; n < 2; ++n) acc[a][b][m][n] = (f32x4){0.f, 0.f, 0.f, 0.f};
        cur = nxt; cA = nA; cB = nB; ++ui;
        if (wr == 1) PG8_BAR;
    }
    PG8_WAIT_V(0);
    PG8_BAR;
#undef PG8_SA
#undef PG8_SB
#undef PG8_STAGE
#undef PG8_LDA
#undef PG8_LDB
#undef PG8_MMA
#undef PG8_WAIT_V
#undef PG8_WAIT_L
#undef PG8_BAR
#undef PG8_SCHED
}
}

__device__ __forceinline__ u32x4 pack8(const f32x4& a, const f32x4& b) { u32x4 w; w.x = cvt_pk_bf16(a[0], a[1]); w.y = cvt_pk_bf16(a[2], a[3]); w.z = cvt_pk_bf16(b[0], b[1]); w.w = cvt_pk_bf16(b[2], b[3]); return w; }
__device__ __forceinline__ void unpack8(const u32x4& w, float (&v)[8]) { v[0] = bf_lo(w.x); v[1] = bf_hi(w.x); v[2] = bf_lo(w.y); v[3] = bf_hi(w.y); v[4] = bf_lo(w.z); v[5] = bf_hi(w.z); v[6] = bf_lo(w.w); v[7] = bf_hi(w.w); }

struct FIn {
    bf16_t* proj; bf16_t* krope;
    __device__ __forceinline__ void operator()(int row, int col, int pn, const f32x4& a, const f32x4& b) const {
        if (pn < 18) *(u32x4*)(proj + (size_t)row * PW + col) = pack8(a, b);
        else if (col < 4608 + 32) *(u32x4*)(krope + (size_t)row * 32 + (col - 4608)) = pack8(a, b);
    }
};
struct FPlain { bf16_t* o; int ld;
    __device__ __forceinline__ void operator()(int row, int col, int, const f32x4& a, const f32x4& b) const { *(u32x4*)(o + (size_t)row * ld + col) = pack8(a, b); } };
struct FPoolG {
    bf16_t* proj; const float* scale;
    __device__ __forceinline__ void operator()(int row, int col, int, const f32x4& a, const f32x4& b) const {
        const u32x4 zw = *(const u32x4*)(proj + (size_t)row * PW + C_Z + col); float z[8]; unpack8(zw, z);
        const f32x4 s0 = *(const f32x4*)(scale + col), s1 = *(const f32x4*)(scale + col + 4);
        f32x4 r0, r1;
#pragma unroll
        for (int i = 0; i < 4; ++i) { r0[i] = a[i] * s0[i] * siluf_(z[i]); r1[i] = b[i] * s1[i] * siluf_(z[4 + i]); }
        *(u32x4*)(proj + (size_t)row * PW + C_P1Y + col) = pack8(r0, r1);
    }
};
struct FPoolUp {
    bf16_t* proj;
    __device__ __forceinline__ void operator()(int row, int col, int, const f32x4& a, const f32x4& b) const {
        const u32x4 gw = *(const u32x4*)(proj + (size_t)row * PW + C_GP + col); float g[8]; unpack8(gw, g);
        f32x4 r0, r1;
#pragma unroll
        for (int i = 0; i < 4; ++i) { r0[i] = a[i] * sigmoidf_(g[i]); r1[i] = b[i] * sigmoidf_(g[4 + i]); }
        *(u32x4*)(proj + (size_t)row * PW + C_MPOOL + col) = pack8(r0, r1);
    }
};
struct FMlaUp {
    const bf16_t* proj; bf16_t* merged;
    __device__ __forceinline__ void operator()(int row, int col, int, const f32x4& a, const f32x4& b) const {
        const u32x4 gw = *(const u32x4*)(proj + (size_t)row * PW + C_GM + col); float g[8]; unpack8(gw, g);
        const u32x4 pw = *(const u32x4*)(proj + (size_t)row * PW + C_MPOOL + col); float p[8]; unpack8(pw, p);
        f32x4 r0, r1;
#pragma unroll
        for (int i = 0; i < 4; ++i) { r0[i] = a[i] * sigmoidf_(g[i]) + p[i]; r1[i] = b[i] * sigmoidf_(g[4 + i]) + p[4 + i]; }
        *(u32x4*)(merged + (size_t)row * 1024 + col) = pack8(r0, r1);
    }
};
__device__ __forceinline__ float* hres_row(float* out, float* metah, int row) {
    const int b = row / LP, t = row - b * LP - PADF;
    if (t < 0) return nullptr;
    if (t < NMETA) return metah + (size_t)(b * NMETA + t) * DM;
    return out + ((size_t)b * SEQ + (t - NMETA)) * DM;
}
struct FOut {
    float* out; float* metah;
    __device__ __forceinline__ void operator()(int row, int col, int, const f32x4& a, const f32x4& b) const {
        float* r = hres_row(out, metah, row);
        if (r) { f32x4* p = (f32x4*)(r + col); p[0] = p[0] + a; p[1] = p[1] + b; }
    }
};


enum { K_IN = 0, K_PLAIN = 1, K_POOLG = 2, K_POOLUP = 3, K_MLAUP = 4, K_OUT = 5 };
struct EpiAll {
    int kind; bf16_t* proj; bf16_t* aux; int ld; const float* scale; float* out; float* metah;
    __device__ __forceinline__ void operator()(const f32x4 (&acc)[2][2][4][2], const pg8::Unit& u, int wr, int wc, int fr, int fq) const {
        switch (kind) {
            case K_IN:     { pg8::Epi<FIn> e{{proj, aux}}; e(acc, u, wr, wc, fr, fq); } break;
            case K_PLAIN:  { pg8::Epi<FPlain> e{{aux, ld}}; e(acc, u, wr, wc, fr, fq); } break;
            case K_POOLG:  { pg8::Epi<FPoolG> e{{proj, scale}}; e(acc, u, wr, wc, fr, fq); } break;
            case K_POOLUP: { pg8::Epi<FPoolUp> e{{proj}}; e(acc, u, wr, wc, fr, fq); } break;
            case K_MLAUP:  { pg8::Epi<FMlaUp> e{{proj, aux}}; e(acc, u, wr, wc, fr, fq); } break;
            default:       { pg8::Epi<FOut> e{{out, metah}}; e(acc, u, wr, wc, fr, fq); } break;
        }
    }
};
__device__ __forceinline__ void tr_item(const float* W, int ldw, int k0, int n0, bf16_t* WT, int ldt, int drow0, int dk0, LAS float* scr, int lane) {
#pragma unroll 8
    for (int i = 0; i < 32; ++i) { const int kk = 2 * i + (lane >> 5); scr[kk * 33 + (lane & 31)] = W[(size_t)(k0 + kk) * ldw + n0 + (lane & 31)]; }
    LDS_WAIT(); asm volatile("" ::: "memory");
    const int c = lane & 7;
#pragma unroll
    for (int j = 0; j < 4; ++j) { const int n = (lane >> 3) + 8 * j; const LAS float* s = scr + (8 * c) * 33 + n;
        u32x4 o; o.x = cvt_pk_bf16(s[0 * 33], s[1 * 33]); o.y = cvt_pk_bf16(s[2 * 33], s[3 * 33]); o.z = cvt_pk_bf16(s[4 * 33], s[5 * 33]); o.w = cvt_pk_bf16(s[6 * 33], s[7 * 33]);
        *(u32x4*)(WT + (size_t)(drow0 + n) * ldt + dk0 + 8 * c) = o; }
    LDS_WAIT(); asm volatile("" ::: "memory");
}
__device__ __forceinline__ void convert_weights(const Args& a, int l, LAS unsigned char* lds, int gw, int NGW, int wave, int lane) {
    LAS float* scr = (LAS float*)(lds + wave * 16384);
    unsigned char* wb = a.ws + WS_W;
    bf16_t* WinT = (bf16_t*)(wb + W_IN); bf16_t* WqT = (bf16_t*)(wb + W_Q); bf16_t* WkvT = (bf16_t*)(wb + W_KV); bf16_t* WgT = (bf16_t*)(wb + W_G);
    bf16_t* WpuT = (bf16_t*)(wb + W_PU); bf16_t* WmuT = (bf16_t*)(wb + W_MU); bf16_t* WoT = (bf16_t*)(wb + W_O);
    const float* w_in = a.w_in + (size_t)l * 1024 * DIN; const float* w_g = a.pool_wg + (size_t)l * 4 * 128 * 128; const float* w_pu = a.pool_wu + (size_t)l * 512 * 1024;
    const float* w_qb = a.w_qb + (size_t)l * 768 * 768; const float* w_kvb = a.w_kvb + (size_t)l * 256 * 1024; const float* w_mu = a.mla_wu + (size_t)l * 512 * 1024; const float* w_o = a.w_out + (size_t)l * 1024 * 1024;
    constexpr int I_IN = 16 * 145, I_Q = 12 * 24, I_KV = 4 * 32, I_G = 4 * 2 * 4, I_PU = 8 * 32, I_MU = 8 * 32, I_O = 16 * 32;
    constexpr int NITEMS = I_IN + I_Q + I_KV + I_G + I_PU + I_MU + I_O;
    for (int it = gw; it < NITEMS; it += NGW) {
        int r = it;
        if (r < I_IN) { const int kb = r / 145, nb = r % 145, n0 = nb * 32; const int d = (n0 < 2048) ? n0 : (n0 < 2080 ? 4608 : n0 - 32);
            tr_item(w_in, DIN, kb * 64, n0, WinT, 1024, d, kb * 64, scr, lane); continue; } r -= I_IN;
        if (r < I_Q) { const int kb = r / 24, nb = r % 24; tr_item(w_qb, 768, kb * 64, nb * 32, WqT, 768, nb * 32, kb * 64, scr, lane); continue; } r -= I_Q;
        if (r < I_KV) { const int kb = r / 32, nb = r % 32; tr_item(w_kvb, 1024, kb * 64, nb * 32, WkvT, 256, nb * 32, kb * 64, scr, lane); continue; } r -= I_KV;
        if (r < I_G) { const int g = r / 8, kb = (r % 8) / 4, nb = r % 4;
            tr_item(w_g + (size_t)g * 128 * 128, 128, kb * 64, nb * 32, WgT, 256, g * 128 + nb * 32, 128 * (g & 1) + kb * 64, scr, lane);
            { const int n = lane >> 1, half = lane & 1; u32x4 z = (u32x4){0u, 0u, 0u, 0u}; if (n < 32) { bf16_t* p = WgT + (size_t)(g * 128 + nb * 32 + n) * 256 + 128 * (1 - (g & 1)) + kb * 64 + half * 32;
                ((u32x4*)p)[0] = z; ((u32x4*)p)[1] = z; ((u32x4*)p)[2] = z; ((u32x4*)p)[3] = z; } }
            continue; } r -= I_G;
        if (r < I_PU) { const int kb = r / 32, nb = r % 32; tr_item(w_pu, 1024, kb * 64, nb * 32, WpuT, 512, nb * 32, kb * 64, scr, lane); continue; } r -= I_PU;
        if (r < I_MU) { const int kb = r / 32, nb = r % 32; tr_item(w_mu, 1024, kb * 64, nb * 32, WmuT, 512, nb * 32, kb * 64, scr, lane); continue; } r -= I_MU;
        { const int kb = r / 32, nb = r % 32; tr_item(w_o, 1024, kb * 64, nb * 32, WoT, 1024, nb * 32, kb * 64, scr, lane); }
    }
    { const int n16 = 224 * 1024 * 2 / 16; u32x4* z = (u32x4*)(WinT + (size_t)4640 * 1024); for (int i = gw * 64 + lane; i < n16; i += NGW * 64) z[i] = (u32x4){0u, 0u, 0u, 0u}; }
}

__device__ __forceinline__ void norm_row_to_h(const float* src, const float* gain, bf16_t* dst, int lane) {
    unsigned long long* o8 = (unsigned long long*)dst + lane;
    if (!src) {
#pragma unroll
        for (int j = 0; j < 4; ++j) o8[64 * j] = 0ull;
        return; }
    const f32x4* xr = (const f32x4*)src + lane; const f32x4* gr = (const f32x4*)gain + lane;
    f32x4 v[4]; float s = 0.f;
#pragma unroll
    for (int j = 0; j < 4; ++j) { v[j] = xr[64 * j]; s += (v[j].x * v[j].x + v[j].y * v[j].y) + (v[j].z * v[j].z + v[j].w * v[j].w); }
    const float inv = 1.0f / sqrtf(wave_sum(s) * (1.f / DM) + EPS);
#pragma unroll
    for (int j = 0; j < 4; ++j) { const f32x4 g = gr[64 * j]; const f32x4 y = v[j] * inv * g;
        o8[64 * j] = (unsigned long long)cvt_pk_bf16(y.x, y.y) | ((unsigned long long)cvt_pk_bf16(y.z, y.w) << 32); }
}

__constant__ double c_inv_freq[16] = {1.0, 0.5623413251903491, 0.31622776601683794, 0.1778279410038923, 0.1, 0.05623413251903491, 0.03162277660168379, 0.01778279410038923,
                                       0.01, 0.005623413251903491, 0.0031622776601683794, 0.0017782794100389228, 0.001, 0.0005623413251903491, 0.00031622776601683794, 0.00017782794100389227};
__device__ __forceinline__ void sincos_d(double ang, float& c, float& s) {
    const double k = rint(ang * 0.6366197723675814); const double y = fma(-k, 6.123233995736766e-17, fma(-k, 1.5707963267948966, ang));
    const double y2 = y * y;
    const double sn = y * (1.0 - y2 / 6.0 * (1.0 - y2 / 20.0 * (1.0 - y2 / 42.0 * (1.0 - y2 / 72.0 * (1.0 - y2 / 110.0 * (1.0 - y2 / 156.0))))));
    const double cs = 1.0 - y2 / 2.0 * (1.0 - y2 / 12.0 * (1.0 - y2 / 30.0 * (1.0 - y2 / 56.0 * (1.0 - y2 / 90.0 * (1.0 - y2 / 132.0 * (1.0 - y2 / 182.0))))));
    const int q = ((int)(long long)k) & 3;
    const double cc = (q == 0) ? cs : (q == 1) ? -sn : (q == 2) ? -cs : sn;
    const double ss = (q == 0) ? sn : (q == 1) ? cs : (q == 2) ? -sn : -cs;
    c = (float)cc; s = (float)ss;
}

__device__ __forceinline__ void phase_init(const Args& a, LAS unsigned char* lds, int vcu, int NGW) {
    const int tid = opaque_tid(), lane = tid & 63, wave = __builtin_amdgcn_readfirstlane(tid >> 6), gw = vcu * 8 + wave;
    bf16_t* H = (bf16_t*)(a.ws + WS_H); float* metah = (float*)(a.ws + WS_METAH); float* rope = (float*)(a.ws + WS_ROPE);
    for (int m = gw; m < MP; m += NGW) {
        const int b = m / LP, t = m - b * LP - PADF;
        float* dstrow = hres_row(a.out, metah, m);
        const float* src = (t < 0) ? nullptr : (t < NMETA ? a.meta + (size_t)t * DM : a.x + ((size_t)b * SEQ + (t - NMETA)) * DM);
        if (src) { const f32x4* s4 = (const f32x4*)src + lane; f32x4* d4 = (f32x4*)dstrow + lane;
#pragma unroll
            for (int j = 0; j < 4; ++j) d4[64 * j] = s4[64 * j]; }
        norm_row_to_h(src, a.norm_gain, H + (size_t)m * DM, lane);
        if (lane < 16) {
            float c = 1.f, s = 0.f;
            if (t >= 0) { const int p = (t < NMETA) ? t : a.pos[b * SEQ + (t - NMETA)] + NMETA; sincos_d((double)p * c_inv_freq[lane], c, s); }
            rope[(size_t)m * 32 + lane] = c; rope[(size_t)m * 32 + 16 + lane] = s;
        }
    }
    convert_weights(a, 0, lds, gw, NGW, wave, lane);
}

__device__ __forceinline__ void phase_rows(const Args& a, int l, int vcu, int NGW) {
    const int tid = opaque_tid(), lane = tid & 63, wave = __builtin_amdgcn_readfirstlane(tid >> 6), gw = vcu * 8 + wave;
    bf16_t* proj = (bf16_t*)(a.ws + WS_PROJ); bf16_t* mixed = (bf16_t*)(a.ws + WS_H);
    const float* gq = a.qa_gain + (size_t)l * 768; const float* gkv = a.kva_gain + (size_t)l * 256;
    f32x4 gqv[3]; f32x4 gkvv;
#pragma unroll
    for (int j = 0; j < 3; ++j) gqv[j] = *(const f32x4*)(gq + 4 * (lane + 64 * j));
    gkvv = *(const f32x4*)(gkv + 4 * lane);
    const int g = lane >> 4, w = 2 << g;
    for (int ch = gw; ch < MP / 16; ch += NGW) {
        const int r0 = ch * 16, p0 = r0 % LP;
        float S[8];
#pragma unroll
        for (int i = 0; i < 8; ++i) S[i] = 0.f;
        for (int j = 1; j < w; ++j) if (p0 - j >= 0) { const u32x4 uw = *(const u32x4*)(proj + (size_t)(r0 - j) * PW + C_U + 8 * lane); float u[8]; unpack8(uw, u);
#pragma unroll
            for (int i = 0; i < 8; ++i) S[i] += u[i]; }
        for (int i = 0; i < 16; ++i) {
            const int m = r0 + i, p = p0 + i, t = p - PADF;
            bf16_t* prow = proj + (size_t)m * PW;
            { u32x2 v[3]; float f[3][4]; float s = 0.f;
#pragma unroll
              for (int j = 0; j < 3; ++j) { v[j] = *(const u32x2*)(prow + C_CQ + 4 * (lane + 64 * j)); f[j][0] = bf_lo(v[j].x); f[j][1] = bf_hi(v[j].x); f[j][2] = bf_lo(v[j].y); f[j][3] = bf_hi(v[j].y);
                  s += (f[j][0] * f[j][0] + f[j][1] * f[j][1]) + (f[j][2] * f[j][2] + f[j][3] * f[j][3]); }
              const float inv = 1.0f / sqrtf(wave_sum(s) * (1.f / 768.f) + EPS);
#pragma unroll
              for (int j = 0; j < 3; ++j) { u32x2 o; o.x = cvt_pk_bf16(f[j][0] * inv * gqv[j][0], f[j][1] * inv * gqv[j][1]); o.y = cvt_pk_bf16(f[j][2] * inv * gqv[j][2], f[j][3] * inv * gqv[j][3]);
                  *(u32x2*)(prow + C_CQ + 4 * (lane + 64 * j)) = o; } }
            { const u32x2 v = *(const u32x2*)(prow + C_CKV + 4 * lane); const float f0 = bf_lo(v.x), f1 = bf_hi(v.x), f2 = bf_lo(v.y), f3 = bf_hi(v.y);
              const float inv = 1.0f / sqrtf(wave_sum((f0 * f0 + f1 * f1) + (f2 * f2 + f3 * f3)) * (1.f / 256.f) + EPS);
              u32x2 o; o.x = cvt_pk_bf16(f0 * inv * gkvv[0], f1 * inv * gkvv[1]); o.y = cvt_pk_bf16(f2 * inv * gkvv[2], f3 * inv * gkvv[3]);
              *(u32x2*)(prow + C_CKV + 4 * lane) = o; }
            { const u32x4 uw = *(const u32x4*)(prow + C_U + 8 * lane); float u[8]; unpack8(uw, u);
#pragma unroll
              for (int k = 0; k < 8; ++k) S[k] += u[k];
              f32x4 r0v = (f32x4){0.f, 0.f, 0.f, 0.f}, r1v = r0v;
              if (t >= 0) { const int cnt = (t + 1 < w) ? (t + 1) : w; const float ic = 1.0f / (float)cnt;
#pragma unroll
                  for (int k = 0; k < 4; ++k) { r0v[k] = S[k] * ic - u[k]; r1v[k] = S[4 + k] * ic - u[4 + k]; } }
              *(u32x4*)(mixed + (size_t)m * 512 + 8 * lane) = pack8(r0v, r1v);
              if (p - (w - 1) >= 0) { const u32x4 ow = *(const u32x4*)(proj + (size_t)(m - (w - 1)) * PW + C_U + 8 * lane); float o[8]; unpack8(ow, o);
#pragma unroll
                  for (int k = 0; k < 8; ++k) S[k] -= o[k]; } }
        }
    }
}

__device__ __forceinline__ void phase_kprep(const Args& a, int l, int vcu, int NGW) {
    const int tid = opaque_tid(), lane = tid & 63, wave = __builtin_amdgcn_readfirstlane(tid >> 6), gw = vcu * 8 + wave;
    const bf16_t* kvraw = (const bf16_t*)(a.ws + WS_KVRAW); const bf16_t* krope = (const bf16_t*)(a.ws + WS_KROPE); const float* rope = (const float*)(a.ws + WS_ROPE);
    bf16_t* Kb = (bf16_t*)(a.ws + WS_H);
    const float* gk = a.kn_gain + (size_t)l * 96;
    const int h = lane >> 3, s = lane & 7;
    const f32x4 g0 = *(const f32x4*)(gk + 8 * s), g1 = *(const f32x4*)(gk + 8 * s + 4);
    const float gr1a = gk[64 + 2 * s], gr1b = gk[64 + 2 * s + 1], gr2a = gk[80 + 2 * s], gr2b = gk[80 + 2 * s + 1];
    for (int m = gw; m < MP; m += NGW) {
        const int b = m / LP, p = m - b * LP;
        const u32x4 kw = *(const u32x4*)(kvraw + (size_t)m * 1024 + h * 128 + 8 * s); float k[8]; unpack8(kw, k);
        const unsigned r1 = *(const unsigned*)(krope + (size_t)m * 32 + 2 * s), r2 = *(const unsigned*)(krope + (size_t)m * 32 + 16 + 2 * s);
        const float x1a = bf_lo(r1), x1b = bf_hi(r1), x2a = bf_lo(r2), x2b = bf_hi(r2);
        float ss = (x1a * x1a + x1b * x1b) + (x2a * x2a + x2b * x2b);
#pragma unroll
        for (int i = 0; i < 8; ++i) ss += k[i] * k[i];
        ss += __shfl_xor(ss, 1); ss += __shfl_xor(ss, 2); ss += __shfl_xor(ss, 4);
        const float inv = 1.0f / sqrtf(ss * (1.f / 96.f) + EPS);
        f32x4 o0, o1;
#pragma unroll
        for (int i = 0; i < 4; ++i) { o0[i] = k[i] * inv * g0[i]; o1[i] = k[4 + i] * inv * g1[i]; }
        const float c0 = rope[(size_t)m * 32 + 2 * s], c1 = rope[(size_t)m * 32 + 2 * s + 1], s0 = rope[(size_t)m * 32 + 16 + 2 * s], s1 = rope[(size_t)m * 32 + 16 + 2 * s + 1];
        const float y1a = x1a * inv * gr1a, y1b = x1b * inv * gr1b, y2a = x2a * inv * gr2a, y2b = x2b * inv * gr2b;
        bf16_t* dst = Kb + ((size_t)(b * NH + h) * LP + p) * 96;
        *(u32x4*)(dst + 8 * s) = pack8(o0, o1);
        *(unsigned*)(dst + 64 + 2 * s) = cvt_pk_bf16(y1a * c0 - y2a * s0, y1b * c1 - y2b * s1);
        *(unsigned*)(dst + 80 + 2 * s) = cvt_pk_bf16(y2a * c0 + y1a * s0, y2b * c1 + y1b * s1);
    }
}

constexpr int KPITCH = 208, VPITCH = 144, KBUF = 64 * KPITCH, VBUF = 64 * VPITCH;
constexpr float QSCALE = 0.1472444460259031f;
constexpr float MASKV = -1e30f;
__device__ __forceinline__ int kvmap(int r, int hi) { return 8 * hi + r + ((r >= 8) ? 8 : 0); }

__device__ __forceinline__ void attn_unit(const Args& a, int l, int b, int h, int R0, bool special, LAS unsigned char* lds) {
    const int tid = opaque_tid(), lane = tid & 63, wave = __builtin_amdgcn_readfirstlane(tid >> 6), r32 = lane & 31, hi = lane >> 5;
    const bf16_t* qraw = (const bf16_t*)(a.ws + WS_QRAW); const bf16_t* Kb = (const bf16_t*)(a.ws + WS_H); const bf16_t* kvraw = (const bf16_t*)(a.ws + WS_KVRAW);
    const float* rope = (const float*)(a.ws + WS_ROPE); bf16_t* proj = (bf16_t*)(a.ws + WS_PROJ);
    const float* gq = a.qn_gain + (size_t)l * 96;
    const int qp = R0 + 32 * wave + r32;
    const size_t mq = (size_t)b * LP + qp;
    const int TL = (R0 + 255) / 64;
    const bf16_t* Kh = Kb + (size_t)(b * NH + h) * LP * 96;
    const bf16_t* Vh = kvraw + (size_t)b * LP * 1024 + h * 128 + 64 + 8 * wave;
    LAS unsigned char* KB0 = lds; LAS unsigned char* VB0 = lds + 2 * KBUF;
    u32x4 kreg0, kreg1, vreg;
    const bool k2 = tid < 256;
#define ATT_LOAD(t) do { const bf16_t* kt = Kh + (size_t)(t) * 64 * 96; kreg0 = *(const u32x4*)(kt + (size_t)tid * 8); if (k2) kreg1 = *(const u32x4*)(kt + (size_t)(tid + 512) * 8); \
        vreg = *(const u32x4*)(Vh + (size_t)((t) * 64 + lane) * 1024); } while (0)
#define ATT_WRITE(t) do { LAS unsigned char* kb = KB0 + ((t) & 1) * KBUF; LAS unsigned char* vb = VB0 + ((t) & 1) * VBUF; \
        { const int c = tid; *(LAS u32x4*)(kb + (c / 12) * KPITCH + (c % 12) * 16) = kreg0; } \
        if (k2) { const int c = tid + 512; *(LAS u32x4*)(kb + (c / 12) * KPITCH + (c % 12) * 16) = kreg1; } \
        { LAS unsigned short* vp = (LAS unsigned short*)(vb + (8 * wave) * VPITCH + lane * 2); \
          vp[0 * (VPITCH / 2)] = (unsigned short)(vreg.x & 0xffff); vp[1 * (VPITCH / 2)] = (unsigned short)(vreg.x >> 16); vp[2 * (VPITCH / 2)] = (unsigned short)(vreg.y & 0xffff); vp[3 * (VPITCH / 2)] = (unsigned short)(vreg.y >> 16); \
          vp[4 * (VPITCH / 2)] = (unsigned short)(vreg.z & 0xffff); vp[5 * (VPITCH / 2)] = (unsigned short)(vreg.z >> 16); vp[6 * (VPITCH / 2)] = (unsigned short)(vreg.w & 0xffff); vp[7 * (VPITCH / 2)] = (unsigned short)(vreg.w >> 16); } } while (0)
    ATT_LOAD(1);
    bf16x8 qr[6];
    {
        float qf[6][8]; float ss = 0.f;
        const bf16_t* qs = qraw + mq * 768 + h * 96 + 8 * hi;
#pragma unroll
        for (int d0 = 0; d0 < 6; ++d0) { const u32x4 w = *(const u32x4*)(qs + 16 * d0); unpack8(w, qf[d0]);
#pragma unroll
            for (int i = 0; i < 8; ++i) ss += qf[d0][i] * qf[d0][i]; }
        ss += __shfl_xor(ss, 32);
        const float inv = 1.0f / sqrtf(ss * (1.f / 96.f) + EPS);
#pragma unroll
        for (int d0 = 0; d0 < 6; ++d0) { const f32x4 g0 = *(const f32x4*)(gq + 16 * d0 + 8 * hi), g1 = *(const f32x4*)(gq + 16 * d0 + 8 * hi + 4);
#pragma unroll
            for (int i = 0; i < 4; ++i) { qf[d0][i] *= inv * g0[i]; qf[d0][4 + i] *= inv * g1[i]; } }
        const float* cs = rope + mq * 32 + 8 * hi;
        const f32x4 c0 = *(const f32x4*)(cs), c1 = *(const f32x4*)(cs + 4), s0 = *(const f32x4*)(cs + 16), s1 = *(const f32x4*)(cs + 20);
#pragma unroll
        for (int i = 0; i < 8; ++i) { const float c = (i < 4) ? c0[i & 3] : c1[i & 3], s = (i < 4) ? s0[i & 3] : s1[i & 3]; const float x1 = qf[4][i], x2 = qf[5][i];
            qf[4][i] = x1 * c - x2 * s; qf[5][i] = x2 * c + x1 * s; }
#pragma unroll
        for (int d0 = 0; d0 < 6; ++d0) { u32x4 w; w.x = cvt_pk_bf16(qf[d0][0] * QSCALE, qf[d0][1] * QSCALE); w.y = cvt_pk_bf16(qf[d0][2] * QSCALE, qf[d0][3] * QSCALE);
            w.z = cvt_pk_bf16(qf[d0][4] * QSCALE, qf[d0][5] * QSCALE); w.w = cvt_pk_bf16(qf[d0][6] * QSCALE, qf[d0][7] * QSCALE); qr[d0] = __builtin_bit_cast(bf16x8, w); }
    }
    ATT_WRITE(1);
    LDS_WAIT(); __builtin_amdgcn_s_barrier();
    float mref = 0.f, lsum = 0.f; f32x16 o0 = {}, o1 = {};
    const int krow = kvmap((r32 & 3) + 4 * (r32 >> 3), (r32 >> 2) & 1);
    const int qmin = R0 + 32 * wave;
    for (int t = 1; t <= TL; ++t) {
        if (t < TL) ATT_LOAD(t + 1);
        if (64 * t <= qmin + 31) {
            const LAS unsigned char* kb = KB0 + (t & 1) * KBUF + krow * KPITCH + 16 * hi; const LAS unsigned char* vb = VB0 + (t & 1) * VBUF + r32 * VPITCH + 16 * hi;
            f32x16 p0 = {}, p1 = {};
#pragma unroll
            for (int d0 = 0; d0 < 6; ++d0) { const bf16x8 ka = *(const LAS bf16x8*)(kb + 32 * d0), kc = *(const LAS bf16x8*)(kb + 32 * KPITCH + 32 * d0);
                p0 = __builtin_amdgcn_mfma_f32_32x32x16_bf16(ka, qr[d0], p0, 0, 0, 0); p1 = __builtin_amdgcn_mfma_f32_32x32x16_bf16(kc, qr[d0], p1, 0, 0, 0); }
            if (t == 1 || 64 * t + 63 > qmin) {
#pragma unroll
                for (int r = 0; r < 16; ++r) { const int kv = 64 * t + kvmap(r, hi); if (!(kv <= qp && kv >= PADF)) p0[r] = MASKV; if (!(kv + 32 <= qp && kv + 32 >= PADF)) p1[r] = MASKV; }
            }
            float rm = fmaxf(p0[0], p1[0]);
#pragma unroll
            for (int r = 1; r < 16; ++r) rm = fmaxf(rm, fmaxf(p0[r], p1[r]));
            rm = fmaxf(rm, __shfl_xor(rm, 32));
            if (t == 1) mref = rm;
            else if (__any(rm > mref + 8.f)) { const float mn = fmaxf(mref, rm); const float f = __builtin_amdgcn_exp2f(mref - mn); mref = mn; lsum *= f;
#pragma unroll
                for (int r = 0; r < 16; ++r) { o0[r] *= f; o1[r] *= f; } }
            float ps = 0.f;
#pragma unroll
            for (int r = 0; r < 16; ++r) { p0[r] = __builtin_amdgcn_exp2f(p0[r] - mref); p1[r] = __builtin_amdgcn_exp2f(p1[r] - mref); ps += p0[r] + p1[r]; }
            lsum += ps;
            bf16x8 pa[4];
            { u32x4 w; w.x = cvt_pk_bf16(p0[0], p0[1]); w.y = cvt_pk_bf16(p0[2], p0[3]); w.z = cvt_pk_bf16(p0[4], p0[5]); w.w = cvt_pk_bf16(p0[6], p0[7]); pa[0] = __builtin_bit_cast(bf16x8, w);
              w.x = cvt_pk_bf16(p0[8], p0[9]); w.y = cvt_pk_bf16(p0[10], p0[11]); w.z = cvt_pk_bf16(p0[12], p0[13]); w.w = cvt_pk_bf16(p0[14], p0[15]); pa[1] = __builtin_bit_cast(bf16x8, w);
              w.x = cvt_pk_bf16(p1[0], p1[1]); w.y = cvt_pk_bf16(p1[2], p1[3]); w.z = cvt_pk_bf16(p1[4], p1[5]); w.w = cvt_pk_bf16(p1[6], p1[7]); pa[2] = __builtin_bit_cast(bf16x8, w);
              w.x = cvt_pk_bf16(p1[8], p1[9]); w.y = cvt_pk_bf16(p1[10], p1[11]); w.z = cvt_pk_bf16(p1[12], p1[13]); w.w = cvt_pk_bf16(p1[14], p1[15]); pa[3] = __builtin_bit_cast(bf16x8, w); }
#pragma unroll
            for (int k = 0; k < 4; ++k) { const bf16x8 va = *(const LAS bf16x8*)(vb + 32 * k), vc = *(const LAS bf16x8*)(vb + 32 * VPITCH + 32 * k);
                o0 = __builtin_amdgcn_mfma_f32_32x32x16_bf16(va, pa[k], o0, 0, 0, 0); o1 = __builtin_amdgcn_mfma_f32_32x32x16_bf16(vc, pa[k], o1, 0, 0, 0); }
        }
        if (t < TL) ATT_WRITE(t + 1);
        LDS_WAIT(); __builtin_amdgcn_s_barrier();
    }
#undef ATT_LOAD
#undef ATT_WRITE
    lsum += __shfl_xor(lsum, 32);
    const float il = (lsum > 0.f) ? 1.0f / lsum : 0.f;
    if (!(special && wave >= 4)) {
        bf16_t* prow = proj + mq * PW;
#pragma unroll
        for (int db = 0; db < 2; ++db)
#pragma unroll
            for (int g = 0; g < 4; ++g) { const int d = 32 * db + 8 * g + 4 * hi;
                const u32x2 zw = *(const u32x2*)(prow + C_ZM + h * 64 + d);
                const float z0 = bf_lo(zw.x), z1 = bf_hi(zw.x), z2 = bf_lo(zw.y), z3 = bf_hi(zw.y);
                const f32x16& o = db ? o1 : o0;
                u32x2 w; w.x = cvt_pk_bf16(o[4 * g] * il * siluf_(z0), o[4 * g + 1] * il * siluf_(z1)); w.y = cvt_pk_bf16(o[4 * g + 2] * il * siluf_(z2), o[4 * g + 3] * il * siluf_(z3));
                *(u32x2*)(prow + C_OZ + h * 64 + d) = w; }
    }
}
__device__ __forceinline__ void phase_attn(const Args& a, int l, LAS unsigned char* lds, int vcu, int G) {
    for (int it = vcu; it < 512; it += G) { const int bh = it >> 4, s = it & 15;
        attn_unit(a, l, bh >> 3, bh & 7, 128 + 256 * (31 - s), false, lds);
        attn_unit(a, l, bh >> 3, bh & 7, 128 + 256 * s, false, lds); }
    for (int it = vcu; it < 32; it += G) attn_unit(a, l, it >> 3, it & 7, 0, true, lds);
}

constexpr int NPHASE = 1 + 8 * DEPTH - 1;
__global__ void __launch_bounds__(512, 2) trunk_fwd(Args a) {
    extern __shared__ __attribute__((aligned(16))) unsigned char lds_raw[];
    LAS unsigned char* lds = (LAS unsigned char*)lds_raw;
    const int G = gridDim.x, bx = blockIdx.x;
    const int vcu = (G % 8 == 0) ? (bx % 8) * (G / 8) + bx / 8 : bx;
    const int NGW = G * 8;
    unsigned char* ws = a.ws;
    bf16_t* H = (bf16_t*)(ws + WS_H); bf16_t* PROJ = (bf16_t*)(ws + WS_PROJ); bf16_t* KROPE = (bf16_t*)(ws + WS_KROPE);
    bf16_t* QRAW = (bf16_t*)(ws + WS_QRAW); bf16_t* KVRAW = (bf16_t*)(ws + WS_KVRAW); float* METAH = (float*)(ws + WS_METAH);
    const bf16_t* WinT = (const bf16_t*)(ws + WS_W + W_IN); const bf16_t* WqT = (const bf16_t*)(ws + WS_W + W_Q); const bf16_t* WkvT = (const bf16_t*)(ws + WS_W + W_KV);
    const bf16_t* WgT = (const bf16_t*)(ws + WS_W + W_G); const bf16_t* WpuT = (const bf16_t*)(ws + WS_W + W_PU); const bf16_t* WmuT = (const bf16_t*)(ws + WS_W + W_MU); const bf16_t* WoT = (const bf16_t*)(ws + WS_W + W_O);
    for (int ph = a.ph_lo; ph < a.ph_hi; ++ph) {
        if (ph == 0) phase_init(a, lds, vcu, NGW);
        else {
            const int l = (ph - 1) >> 3, sp = (ph - 1) & 7;
            if (sp == 1) phase_rows(a, l, vcu, NGW);
            else if (sp == 3) phase_kprep(a, l, vcu, NGW);
            else if (sp == 4) phase_attn(a, l, lds, vcu, G);
            else if (sp == 7) {
                const int tid = opaque_tid(), lane = tid & 63, wave = __builtin_amdgcn_readfirstlane(tid >> 6), gw = vcu * 8 + wave;
                for (int m = gw; m < MP; m += NGW) norm_row_to_h(hres_row(a.out, METAH, m), a.norm_gain + (size_t)(l + 1) * DM, H + (size_t)m * DM, lane);
                convert_weights(a, l + 1, lds, gw, NGW, wave, lane);
            }
            for (int j = 0; j < 3; ++j) {
                pg8::Gemm g{nullptr, 0, nullptr, 0, MP, 0, 0, 0}; EpiAll E{K_PLAIN, PROJ, nullptr, 0, nullptr, a.out, METAH};
                if (sp == 0 && j == 0)      { g.A = H; g.lda = 1024; g.Bt = WinT; g.ldb = 1024; g.N = NIN_PAD; g.K = 1024; E.kind = K_IN; E.aux = KROPE; }
                else if (sp == 2 && j == 0) { g.A = PROJ + C_CQ; g.lda = PW; g.Bt = WqT; g.ldb = 768; g.N = 768; g.K = 768; E.kind = K_PLAIN; E.aux = QRAW; E.ld = 768; }
                else if (sp == 2 && j == 1) { g.A = PROJ + C_CKV; g.lda = PW; g.Bt = WkvT; g.ldb = 256; g.N = 1024; g.K = 256; E.kind = K_PLAIN; E.aux = KVRAW; E.ld = 1024; }
                else if (sp == 2 && j == 2) { g.A = H  ; g.lda = 512; g.Bt = WgT; g.ldb = 256; g.N = 512; g.K = 256; g.apn = 256; E.kind = K_POOLG; E.scale = a.pool_scale + (size_t)l * 512; }
                else if (sp == 3 && j == 0) { g.A = PROJ + C_P1Y; g.lda = PW; g.Bt = WpuT; g.ldb = 512; g.N = 1024; g.K = 512; E.kind = K_POOLUP; }
                else if (sp == 5 && j == 0) { g.A = PROJ + C_OZ; g.lda = PW; g.Bt = WmuT; g.ldb = 512; g.N = 1024; g.K = 512; E.kind = K_MLAUP; E.aux = KVRAW  ; }
                else if (sp == 6 && j == 0) { g.A = KVRAW  ; g.lda = 1024; g.Bt = WoT; g.ldb = 1024; g.N = 1024; g.K = 1024; E.kind = K_OUT; }
                else break;
                pg8::StaticOrder S; S.init(MP, g.N, G, bx); pg8::gemm_phase(lds, g, S, E);
            }
        }
        if (ph + 1 < a.ph_hi) { __syncthreads(); cg::this_grid().sync(); }
    }
}

extern "C" void kernel_launch(void* const* d_in, const int* in_sizes, int n_in, void* d_out, int out_size, void* d_ws, size_t ws_size, hipStream_t stream) {
    static int grid = 0;
    if (grid == 0) {
        if (n_in != 16 || out_size != BATCH * SEQ * DM || ws_size < WS_END) { fprintf(stderr, "kernel_launch: unexpected shapes (n_in %d out %d ws %zu)\n", n_in, out_size, ws_size); grid = -1; return; }
        int dev = 0, cus = 0, per_cu = 0;
        hipGetDevice(&dev); hipDeviceGetAttribute(&cus, hipDeviceAttributeMultiprocessorCount, dev);
        if (hipFuncSetAttribute((const void*)trunk_fwd, hipFuncAttributeMaxDynamicSharedMemorySize, LDS_BYTES) != hipSuccess) { fprintf(stderr, "kernel_launch: hipFuncSetAttribute failed\n"); grid = -1; return; }
        if (hipOccupancyMaxActiveBlocksPerMultiprocessor(&per_cu, (const void*)trunk_fwd, 512, LDS_BYTES) != hipSuccess || per_cu < 1) { fprintf(stderr, "kernel_launch: occupancy query says %d\n", per_cu); per_cu = 1; }
        (void)hipGetLastError();
        grid = cus * 1;
    }
    if (grid < 0) return;
    Args a{};
    a.x = (const float*)d_in[0]; a.pos = (const int*)d_in[1]; a.meta = (const float*)d_in[2]; a.norm_gain = (const float*)d_in[3]; a.w_in = (const float*)d_in[4];
    a.pool_wg = (const float*)d_in[5]; a.pool_scale = (const float*)d_in[6]; a.pool_wu = (const float*)d_in[7]; a.qa_gain = (const float*)d_in[8]; a.kva_gain = (const float*)d_in[9];
    a.w_qb = (const float*)d_in[10]; a.w_kvb = (const float*)d_in[11]; a.qn_gain = (const float*)d_in[12]; a.kn_gain = (const float*)d_in[13]; a.mla_wu = (const float*)d_in[14]; a.w_out = (const float*)d_in[15];
    a.out = (float*)d_out; a.ws = (unsigned char*)d_ws;
#if MK_COOP
    a.ph_lo = 0; a.ph_hi = NPHASE;
    void* args[] = {&a};
    hipError_t e = hipLaunchCooperativeKernel((const void*)trunk_fwd, dim3(grid), dim3(512), args, LDS_BYTES, stream);
    if (e != hipSuccess) fprintf(stderr, "cooperative launch failed: %s (grid %d)\n", hipGetErrorString(e), grid);
#else
    for (int ph = 0; ph < NPHASE; ++ph) { a.ph_lo = ph; a.ph_hi = ph + 1; hipLaunchKernelGGL(trunk_fwd, dim3(grid), dim3(512), LDS_BYTES, stream, a); }
#endif
}
```

```cpp
#include <hip/hip_runtime.h>
#include <hip/hip_cooperative_groups.h>
#include <cstdio>
#include <cstdint>
namespace cg = cooperative_groups;

#ifndef MK_COOP
#define MK_COOP 1
#endif

#define LAS __attribute__((address_space(3)))
typedef unsigned short bf16_t;
typedef short bf16x8 __attribute__((ext_vector_type(8)));
typedef float f32x4 __attribute__((ext_vector_type(4)));
typedef float f32x16 __attribute__((ext_vector_type(16)));
typedef unsigned u32x4 __attribute__((ext_vector_type(4)));
typedef unsigned u32x2 __attribute__((ext_vector_type(2)));

constexpr int BATCH = 4, SEQ = 8192, DM = 1024, DEPTH = 4, NMETA = 16;
constexpr int PADF = 112, LP = 8320, MP = BATCH * LP;
constexpr int NH = 8;
constexpr int DIN = 4640;
constexpr float EPS = 1e-6f;
constexpr int PW = 4608;
constexpr int C_U = 0  , C_Z = 512, C_CQ = 1024, C_CKV = 1792, C_ZM = 2048, C_GP = 2560, C_GM = 3584;
constexpr int C_P1Y = 512  , C_MPOOL = 1024  , C_OZ = 0  ;
constexpr int NIN_PAD = 4864;

constexpr size_t MiB = 1u << 20;
constexpr size_t WS_CTL = 0, CTL_ZERO_BYTES = 65536;
constexpr size_t WS_W = 1 * MiB;
constexpr size_t W_IN = 0, W_Q = W_IN + (size_t)NIN_PAD * 1024 * 2, W_KV = W_Q + 768 * 768 * 2, W_G = W_KV + 1024 * 256 * 2,
                 W_PU = W_G + 512 * 256 * 2, W_MU = W_PU + 1024 * 512 * 2, W_O = W_MU + 1024 * 512 * 2  , W_END = W_O + 2 * 1024 * 1024 * 2;
static_assert(W_END <= 18 * MiB, "weights");
constexpr size_t WS_ROPE = 19 * MiB, WS_SSQH = 24 * MiB  , WS_SSQQ = 27 * MiB  , WS_SSQKV = 29 * MiB  ,
                 WS_METAH = 30 * MiB, WS_KROPE = 31 * MiB, WS_H = 34 * MiB  , WS_PROJ = 99 * MiB, WS_QRAW = 392 * MiB  , WS_V = 441 * MiB, WS_END = 474 * MiB;
static_assert(WS_H + (size_t)MP * 1024 * 2 <= WS_PROJ && WS_PROJ + (size_t)MP * PW * 2 <= WS_QRAW && WS_QRAW + (size_t)MP * 768 * 2 <= WS_V && WS_V + (size_t)MP * 512 * 2 <= WS_END && WS_QRAW + (size_t)MP * 1024 * 2 <= WS_END, "ws map");

constexpr int LDS_BYTES = 147456, MISC_OFF = 131072 + 320;

struct Args {
    const float* x; const int* pos; const float* meta; const float* norm_gain; const float* w_in; const float* pool_wg; const float* pool_scale; const float* pool_wu;
    const float* qa_gain; const float* kva_gain; const float* w_qb; const float* w_kvb; const float* qn_gain; const float* kn_gain; const float* mla_wu; const float* w_out;
    float* out; unsigned char* ws; int ph_lo, ph_hi;
};

__device__ __forceinline__ unsigned cvt_pk_bf16(float lo, float hi) { unsigned r; asm volatile("v_cvt_pk_bf16_f32 %0, %1, %2" : "=v"(r) : "v"(lo), "v"(hi)); return r; }
typedef float f32x2_t __attribute__((ext_vector_type(2))); typedef __bf16 bf16x2_t __attribute__((ext_vector_type(2)));
__device__ __forceinline__ unsigned cvtpk_s(float lo, float hi) { f32x2_t v = {lo, hi}; bf16x2_t b = __builtin_convertvector(v, bf16x2_t); return __builtin_bit_cast(unsigned, b); }
__device__ __forceinline__ float bf_lo(unsigned u) { return __uint_as_float(u << 16); }
__device__ __forceinline__ float bf_hi(unsigned u) { return __uint_as_float(u & 0xffff0000u); }
__device__ __forceinline__ float xor32f(float v) { const auto rr = __builtin_amdgcn_permlane32_swap(__float_as_uint(v), __float_as_uint(v), false, false); const unsigned me = __float_as_uint(v); return __uint_as_float(rr[0] == me ? rr[1] : rr[0]); }
__device__ __forceinline__ float xor16f(float v) { return __uint_as_float((unsigned)__builtin_amdgcn_ds_swizzle((int)__float_as_uint(v), 0x401F)); }
template <int M> __device__ __forceinline__ float xorswz(float v) { return __uint_as_float((unsigned)__builtin_amdgcn_ds_swizzle((int)__float_as_uint(v), (M << 10) | 0x1F)); }
__device__ __forceinline__ float wave_sum(float v) {
    v += xorswz<1>(v); v += xorswz<2>(v); v += xorswz<4>(v); v += xorswz<8>(v); v += xorswz<16>(v); v += xor32f(v);
    return v;
}
__device__ __forceinline__ float sigmoidf_(float g) { return __builtin_amdgcn_rcpf(1.f + __expf(-g)); }
__device__ __forceinline__ float siluf_(float z) { return z * sigmoidf_(z); }
#define LDS_WAIT() asm volatile("s_waitcnt lgkmcnt(0)" ::: "memory")
__device__ __forceinline__ u32x4 zero4() { unsigned z = 0u; asm volatile("" : "+v"(z)); return (u32x4){z, z, z, z}; }
__device__ __forceinline__ int opaque_tid(int wv) { int t = wv * 64 + (int)__builtin_amdgcn_mbcnt_hi(~0u, __builtin_amdgcn_mbcnt_lo(~0u, 0u)); asm volatile("" : "+v"(t)); return t; }

#define XB_TMO      128
#define XB_XCNT(j)  (256  + 64 * (j))
#define XB_XSUB(j)  (1280 + 64 * (j))
#define XB_XGEN(j)  (2304 + 64 * (j))
#define XB_TOP      3328
#define XB_TOPGEN   3392
#define XCD_BAR_WORDS 3456
#define XB_SPIN_CAP (1u << 18)

__device__ __forceinline__ unsigned xb_ld(unsigned* p)              { return __hip_atomic_load(p, __ATOMIC_RELAXED, __HIP_MEMORY_SCOPE_AGENT); }
__device__ __forceinline__ unsigned xb_add(unsigned* p, unsigned v) { return __hip_atomic_fetch_add(p, v, __ATOMIC_RELAXED, __HIP_MEMORY_SCOPE_AGENT); }
__device__ __forceinline__ unsigned xb_xcc_id() { return (unsigned)__builtin_amdgcn_s_getreg((3 << 11) | 20) & 0xFu; }
#define XB_SPIN(cond, bar) do { unsigned _sp = 0; while (cond) { __builtin_amdgcn_s_sleep(1); \
    if ((++_sp & 255u) == 0u) { if (xb_ld(&(bar)[XB_TMO])) break; if (_sp > XB_SPIN_CAP) { atomicAdd(&(bar)[XB_TMO], 1u); break; } } } } while (0)

struct XcdBarrier {
    unsigned* bar; unsigned x;
    volatile LAS unsigned* st;
};

__device__ __forceinline__ XcdBarrier xcd_barrier_post(unsigned* bar, volatile LAS unsigned* st, int tid) {
    XcdBarrier b; b.bar = bar; b.x = xb_xcc_id(); b.st = st;
    if (tid == 0) (void)xb_add(&bar[XB_XCNT(b.x)], 1u);
    return b;
}
__device__ __forceinline__ void xcd_barrier_complete(unsigned* bar, unsigned x, unsigned& nloc, unsigned& nx) {
    const unsigned G = gridDim.x * gridDim.y * gridDim.z;
    unsigned sum, cnt, mine, sp = 0u;
    for (;;) {
        sum = 0u; cnt = 0u; mine = 0u;
#pragma unroll
        for (unsigned j = 0; j < 16; ++j) { const unsigned c = xb_ld(&bar[XB_XCNT(j)]); sum += c; cnt += (c > 0u) ? 1u : 0u; mine = (j == x) ? c : mine; }
        if (sum == G) break;
        __builtin_amdgcn_s_sleep(1);
        if ((++sp & 255u) == 0u) { if (xb_ld(&bar[XB_TMO])) break; if (sp > XB_SPIN_CAP) { atomicAdd(&bar[XB_TMO], 1u); break; } }
    }
    nloc = mine > 0u ? mine : 1u; nx = cnt > 0u ? cnt : 1u;
}

__device__ __forceinline__ void xcd_barrier(const XcdBarrier& b, int tid) {
    asm volatile("s_waitcnt vmcnt(0)" ::: "memory");
    __syncthreads();
    if (tid == 0) {
        unsigned* bar = b.bar;
        __builtin_amdgcn_s_waitcnt(0);
        unsigned nloc = b.st[0], nx = b.st[1];
        if (nloc == 0u) { xcd_barrier_complete(bar, b.x, nloc, nx); b.st[0] = nloc; b.st[1] = nx; }
        const unsigned old = xb_add(&bar[XB_XSUB(b.x)], 1u);
        const unsigned gen = old / nloc;
        if (old + 1u == (gen + 1u) * nloc) {
            __builtin_amdgcn_fence(__ATOMIC_RELEASE, "agent");
            asm volatile("s_waitcnt vmcnt(0)" ::: "memory");
            const unsigned og = xb_add(&bar[XB_TOP], 1u);
            const unsigned tg = og / nx;
            if (og + 1u == (tg + 1u) * nx) xb_add(&bar[XB_TOPGEN], 1u);
            else XB_SPIN(xb_ld(&bar[XB_TOPGEN]) == tg, bar);
            __builtin_amdgcn_fence(__ATOMIC_ACQUIRE, "agent");
            xb_add(&bar[XB_XGEN(b.x)], 1u);
            asm volatile("s_waitcnt vmcnt(0)" ::: "memory");
        } else {
            XB_SPIN(xb_ld(&bar[XB_XGEN(b.x)]) == gen, bar);
            __builtin_amdgcn_fence(__ATOMIC_ACQUIRE, "agent");
            asm volatile("s_waitcnt vmcnt(0)" ::: "memory");
        }
    }
    __syncthreads();
}

namespace pg8 {
constexpr int BM = 256, BK = 64, HALF = 128, HTB = HALF * BK * 2, STAGE_BYTES = 8 * HTB, NXCD = 8, WGM = 8;
__host__ __device__ __forceinline__ int lds_byte(int r, int c) { const int st = (r >> 4) * 2 + (c >> 5), rr = r & 15, cc = c & 31, ob = rr * 64 + cc * 2; return st * 1024 + (ob ^ (((ob >> 9) & 1) << 5)); }
__host__ __device__ __forceinline__ void stage_rc(int b, int& R, int& C) { const int st = b / 1024, sb = b % 1024, swz = sb ^ (((sb >> 9) & 1) << 5); R = (st >> 1) * 16 + swz / 64; C = (st & 1) * 32 + (swz % 64) / 2; }
__host__ __device__ __forceinline__ int perm32(int rho) { const int n = rho >> 4, i = rho & 15; return 8 * (i >> 2) + 4 * n + (i & 3); }
struct Unit { int pm, pn; };
struct Gemm { const bf16_t* A; int lda; const bf16_t* Bt; int ldb; int M, N, K; int apn; };
struct StaticOrder {
    int nM, nN, nwg, G, c;
    __device__ void init(int M, int N, int G_, int c_) { nM = M / BM; nN = N / BM; nwg = nM * nN; G = G_; c = c_; }
    __device__ bool next(int i, Unit& u) const {
        const long L = (long)i * G + c; if (L >= nwg) return false;
        int wgid = (int)L; { const int q = nwg / NXCD, r = nwg % NXCD, xcd = wgid % NXCD, off = wgid / NXCD; wgid = (xcd < r ? xcd * (q + 1) : r * (q + 1) + (xcd - r) * q) + off; }
        const int nig = WGM * nN, gid = wgid / nig, fm = gid * WGM, gsz = (nM - fm) < WGM ? (nM - fm) : WGM;
        u.pm = fm + ((wgid % nig) % gsz); u.pn = (wgid % nig) / gsz; return true;
    }
};
template <class F> struct Epi {
    F f;
    __device__ __forceinline__ void operator()(const f32x4 (&acc)[2][2][4][2], const Unit& u, int wr, int wc, int fr, int fq) const {
        const int c0 = u.pn * BM + wc * 32 + 8 * fq;
#pragma unroll
        for (int ai = 0; ai < 2; ++ai)
#pragma unroll
            for (int mp = 0; mp < 4; mp += 2) {
                typename F::Ld ld[2];
#pragma unroll
                for (int m = 0; m < 2; ++m) f.load(ld[m], u.pm * BM + ai * HALF + wr * 64 + (mp + m) * 16 + fr, c0, u.pn, fq);
#pragma unroll
                for (int m = 0; m < 2; ++m) f.apply(ld[m], u.pm * BM + ai * HALF + wr * 64 + (mp + m) * 16 + fr, c0, u.pn, wc, fq, acc[ai][0][mp + m][0], acc[ai][0][mp + m][1], acc[ai][1][mp + m][0], acc[ai][1][mp + m][1]);
            }
    }
};

template <class EpiT>
__device__ __forceinline__ void gemm_phase(LAS unsigned char* lds, const Gemm g, const StaticOrder& S, const EpiT& E, int wv) {
    const int tid = opaque_tid(wv), wid = __builtin_amdgcn_readfirstlane(tid >> 6), lane = tid & 63, wr = wid >> 2, wc = wid & 3, fr = lane & 15, fq = lane >> 4;
    int K = g.K; asm volatile("" : "+s"(K)); const int nt = K / BK;
    unsigned voffA[2], voffB[2];
#pragma unroll
    for (int i = 0; i < 2; ++i) { int R, C; stage_rc(tid * 16 + i * 8192, R, C); const int Rb = (R & ~31) + perm32(R & 31);
        voffA[i] = (unsigned)(R * g.lda + C) * 2u; voffB[i] = (unsigned)(Rb * g.ldb + C) * 2u; }
    const size_t kstep = (size_t)(BK * 2);
    const size_t hA = (size_t)HALF * g.lda * 2, hB = (size_t)HALF * g.ldb * 2;
    const size_t tA = 2 * hA, tB = 2 * hB;
    const unsigned ldsw = (unsigned)wid * 1024u;
    const int aoff = lds_byte(wr * 64 + fr, fq * 8), boff = lds_byte(wc * 32 + fr, fq * 8);
#define PG8_SA(b, h) (((b) * 2 + (h)) * HTB)
#define PG8_SB(b, h) ((4 + (b) * 2 + (h)) * HTB)
#define PG8_STAGE(bufoff, gbase, voff) do { _Pragma("unroll") for (int _i = 0; _i < 2; ++_i) \
        __builtin_amdgcn_global_load_lds((const unsigned*)((const char*)(gbase) + (voff)[_i]), (LAS unsigned*)(lds + (bufoff) + ldsw + _i * 8192), 16, 0, 0); } while (0)
#define PG8_LDA(dst, b, h) do { _Pragma("unroll") for (int m = 0; m < 4; ++m) _Pragma("unroll") for (int k = 0; k < 2; ++k) dst[m][k] = *(const LAS bf16x8*)(lds + PG8_SA(b, h) + aoff + m * 2048 + k * 1024); } while (0)
#define PG8_LDB(dst, b, h) do { _Pragma("unroll") for (int n = 0; n < 2; ++n) _Pragma("unroll") for (int k = 0; k < 2; ++k) dst[n][k] = *(const LAS bf16x8*)(lds + PG8_SB(b, h) + boff + n * 2048 + k * 1024); } while (0)
#define PG8_MMA(ai, bj, At, Bt) do { __builtin_amdgcn_s_setprio(1); _Pragma("unroll") for (int m = 0; m < 4; ++m) _Pragma("unroll") for (int n = 0; n < 2; ++n) _Pragma("unroll") for (int k = 0; k < 2; ++k) \
        acc[ai][bj][m][n] = __builtin_amdgcn_mfma_f32_16x16x32_bf16(Bt[n][k], At[m][k], acc[ai][bj][m][n], 0, 0, 0); __builtin_amdgcn_s_setprio(0); } while (0)
#define PG8_WAIT_V(n) asm volatile("s_waitcnt vmcnt(" #n ")" ::: "memory")
#define PG8_WAIT_L(n) asm volatile("s_waitcnt lgkmcnt(" #n ")" ::: "memory")
#define PG8_BAR __builtin_amdgcn_s_barrier()
#define PG8_SCHED __builtin_amdgcn_sched_barrier(0)
    Unit cur, nxt; int ui = 0;
    if (!S.next(0, cur)) return;
    f32x4 acc[2][2][4][2];
    { float z = 0.f; asm volatile("" : "+v"(z));
#pragma unroll
    for (int a = 0; a < 2; ++a)
#pragma unroll
        for (int b = 0; b < 2; ++b)
#pragma unroll
            for (int m = 0; m < 4; ++m)
#pragma unroll
                for (int n = 0; n < 2; ++n) acc[a][b][m][n] = (f32x4){z, z, z, z}; }
    bf16x8 At[4][2], B0[2][2], B1[2][2];
    const char* cA = (const char*)g.A + (size_t)cur.pm * tA + (size_t)cur.pn * g.apn * 2; const char* cB = (const char*)g.Bt + (size_t)cur.pn * tB;
    PG8_STAGE(PG8_SB(0, 0), cB, voffB); PG8_STAGE(PG8_SB(0, 1), cB + hB, voffB); PG8_STAGE(PG8_SA(0, 0), cA, voffA); PG8_STAGE(PG8_SA(0, 1), cA + hA, voffA);
    if (wr == 1) PG8_BAR;
    PG8_WAIT_V(2); PG8_BAR;
    PG8_STAGE(PG8_SB(1, 0), cB + kstep, voffB); PG8_STAGE(PG8_SA(1, 0), cA + kstep, voffA); PG8_STAGE(PG8_SB(1, 1), cB + hB + kstep, voffB);
    PG8_WAIT_V(6); PG8_BAR;
    for (;;) {
        const bool has_next = S.next(ui + 1, nxt);
        const char* nA = has_next ? (const char*)g.A + (size_t)nxt.pm * tA + (size_t)nxt.pn * g.apn * 2 : cA; const char* nB = has_next ? (const char*)g.Bt + (size_t)nxt.pn * tB : cB;
#pragma unroll 1
        for (int t = 0; t < nt; t += 2) {
            const bool last = (t == nt - 2);
            const char* a1 = cA + (size_t)(t + 1) * kstep;
            const char* a2 = last ? nA : cA + (size_t)(t + 2) * kstep; const char* b2 = last ? nB : cB + (size_t)(t + 2) * kstep;
            const char* a3 = a2 + kstep; const char* b3 = b2 + kstep;
            PG8_LDB(B0, 0, 0); PG8_LDB(B1, 0, 1); PG8_SCHED; PG8_LDA(At, 0, 0); PG8_STAGE(PG8_SA(1, 1), a1 + hA, voffA);
            PG8_WAIT_V(8); PG8_WAIT_L(0); PG8_BAR; PG8_MMA(0, 0, At, B0); PG8_MMA(0, 1, At, B1); PG8_BAR; PG8_SCHED;
            PG8_LDA(At, 0, 1); PG8_STAGE(PG8_SB(0, 0), b2, voffB); PG8_STAGE(PG8_SB(0, 1), b2 + hB, voffB); PG8_STAGE(PG8_SA(0, 0), a2, voffA);
            PG8_WAIT_V(8); PG8_WAIT_L(0); PG8_BAR; PG8_MMA(1, 0, At, B0); PG8_MMA(1, 1, At, B1); PG8_BAR; PG8_SCHED;
            PG8_LDB(B0, 1, 0); PG8_LDB(B1, 1, 1); PG8_SCHED; PG8_LDA(At, 1, 0); PG8_STAGE(PG8_SA(0, 1), a2 + hA, voffA);
            PG8_WAIT_V(8); PG8_WAIT_L(0); PG8_BAR; PG8_MMA(0, 0, At, B0); PG8_MMA(0, 1, At, B1); PG8_BAR; PG8_SCHED;
            PG8_LDA(At, 1, 1); PG8_STAGE(PG8_SB(1, 0), b3, voffB); PG8_STAGE(PG8_SB(1, 1), b3 + hB, voffB); PG8_STAGE(PG8_SA(1, 0), a3, voffA);
            PG8_WAIT_V(8); PG8_WAIT_L(0); PG8_BAR; PG8_MMA(1, 0, At, B0); PG8_MMA(1, 1, At, B1); PG8_BAR; PG8_SCHED;
        }
        if (wr == 0) PG8_BAR;
        E(acc, cur, wr, wc, fr, fq);
        if (!has_next) break;
        { float z = 0.f; asm volatile("" : "+v"(z));
#pragma unroll
        for (int a = 0; a < 2; ++a)
#pragma unroll
            for (int b = 0; b < 2; ++b)
#pragma unroll
                for (int m = 0; m < 4; ++m)
#pragma unroll
                    for (int n = 0; n < 2; ++n) acc[a][b][m][n] = (f32x4){z, z, z, z}; }
        cur = nxt; cA = nA; cB = nB; ++ui;
        if (wr == 1) PG8_BAR;
    }
    PG8_WAIT_V(0);
    PG8_BAR;
#undef PG8_SA
#undef PG8_SB
#undef PG8_STAGE
#undef PG8_LDA
#undef PG8_LDB
#undef PG8_MMA
#undef PG8_WAIT_V
#undef PG8_WAIT_L
#undef PG8_BAR
#undef PG8_SCHED
}
}

__device__ __forceinline__ u32x4 pack8(const f32x4& a, const f32x4& b) { u32x4 w; w.x = cvt_pk_bf16(a[0], a[1]); w.y = cvt_pk_bf16(a[2], a[3]); w.z = cvt_pk_bf16(b[0], b[1]); w.w = cvt_pk_bf16(b[2], b[3]); return w; }
__device__ __forceinline__ void unpack8(const u32x4& w, float (&v)[8]) { v[0] = bf_lo(w.x); v[1] = bf_hi(w.x); v[2] = bf_lo(w.y); v[3] = bf_hi(w.y); v[4] = bf_lo(w.z); v[5] = bf_hi(w.z); v[6] = bf_lo(w.w); v[7] = bf_hi(w.w); }

__device__ __forceinline__ float row_inv16(const float* p16, float invn) {
    const f32x4 a = ((const f32x4*)p16)[0], b = ((const f32x4*)p16)[1], c = ((const f32x4*)p16)[2], d = ((const f32x4*)p16)[3];
    const float s = ((a[0] + a[1]) + (a[2] + a[3])) + ((b[0] + b[1]) + (b[2] + b[3])) + ((c[0] + c[1]) + (c[2] + c[3])) + ((d[0] + d[1]) + (d[2] + d[3]));
    return 1.0f / sqrtf(s * invn + EPS);
}
struct FIn {
    bf16_t* proj; bf16_t* krope; const float* ssqh; float* ssqq; float* ssqkv;
    struct Ld { f32x4 p[4]; };
    __device__ __forceinline__ void load(Ld& d, int row, int, int, int) const {
#pragma unroll
        for (int i = 0; i < 4; ++i) d.p[i] = ((const f32x4*)(ssqh + (size_t)row * 16))[i]; }
    __device__ __forceinline__ void apply(const Ld& d, int row, int c0, int pn, int wc, int fq, const f32x4& a0, const f32x4& b0, const f32x4& a1, const f32x4& b1) const {
        const f32x4 t = (d.p[0] + d.p[1]) + (d.p[2] + d.p[3]);
        const float inv = __builtin_amdgcn_rsqf(((t[0] + t[1]) + (t[2] + t[3])) * (1.f / DM) + EPS);
        const f32x4 v0 = a0 * inv, v1 = b0 * inv, v2 = a1 * inv, v3 = b1 * inv;
        if (pn < 18) { *(u32x4*)(proj + (size_t)row * PW + c0) = pack8(v0, v1); *(u32x4*)(proj + (size_t)row * PW + c0 + 128) = pack8(v2, v3); }
        else if (c0 < 4608 + 32) *(u32x4*)(krope + (size_t)row * 32 + (c0 - 4608)) = pack8(v0, v1);
        if (pn >= 4 && pn < 8) {
            const f32x4 sq = v0 * v0 + v1 * v1 + v2 * v2 + v3 * v3; float ss = (sq[0] + sq[1]) + (sq[2] + sq[3]);
            ss += xor16f(ss); ss += xor32f(ss);
            if (fq == 0) { if (pn < 7) ssqq[(size_t)row * 12 + (pn - 4) * 4 + wc] = ss; else ssqkv[(size_t)row * 4 + wc] = ss; }
        }
    }
};
struct FQ {
    bf16_t* o; const float* ssqq;
    struct Ld { f32x4 p[3]; };
    __device__ __forceinline__ void load(Ld& d, int row, int, int, int) const {
#pragma unroll
        for (int i = 0; i < 3; ++i) d.p[i] = ((const f32x4*)(ssqq + (size_t)row * 12))[i]; }
    __device__ __forceinline__ void apply(const Ld& d, int row, int c0, int, int, int, const f32x4& a0, const f32x4& b0, const f32x4& a1, const f32x4& b1) const {
        const f32x4 t = d.p[0] + d.p[1] + d.p[2];
        const float inv = __builtin_amdgcn_rsqf(((t[0] + t[1]) + (t[2] + t[3])) * (1.f / 768.f) + EPS);
        *(u32x4*)(o + (size_t)row * 768 + c0) = pack8(a0 * inv, b0 * inv); *(u32x4*)(o + (size_t)row * 768 + c0 + 128) = pack8(a1 * inv, b1 * inv); }
};
struct FKV {
    bf16_t* Kb; const bf16_t* krope; const float* rope; const float* ssqkv; const float* gk;
    struct Ld { f32x4 pp, cs, sn; u32x2 r1, r2; };
    __device__ __forceinline__ void load(Ld& d, int row, int, int, int fq) const {
        d.pp = *(const f32x4*)(ssqkv + (size_t)row * 4);
        d.r1 = *(const u32x2*)(krope + (size_t)row * 32 + 4 * fq); d.r2 = *(const u32x2*)(krope + (size_t)row * 32 + 16 + 4 * fq);
        d.cs = *(const f32x4*)(rope + (size_t)row * 32 + 4 * fq); d.sn = *(const f32x4*)(rope + (size_t)row * 32 + 16 + 4 * fq); }
    __device__ __forceinline__ void apply(const Ld& d, int row, int, int pn, int wc, int fq, const f32x4& a0, const f32x4& b0, const f32x4& a1, const f32x4& b1) const {
        const float akv = __builtin_amdgcn_rsqf(((d.pp[0] + d.pp[1]) + (d.pp[2] + d.pp[3])) * (1.f / 256.f) + EPS);
        const f32x4 v0 = a0 * akv, v1 = b0 * akv, v2 = a1 * akv, v3 = b1 * akv;
        const int h = 4 * pn + wc, b = row / LP, p = row - b * LP;
        const f32x4 x1 = (f32x4){bf_lo(d.r1.x), bf_hi(d.r1.x), bf_lo(d.r1.y), bf_hi(d.r1.y)}, x2 = (f32x4){bf_lo(d.r2.x), bf_hi(d.r2.x), bf_lo(d.r2.y), bf_hi(d.r2.y)};
        const f32x4 sq = v0 * v0 + v1 * v1 + v2 * v2 + v3 * v3 + x1 * x1 + x2 * x2;
        float ss = (sq[0] + sq[1]) + (sq[2] + sq[3]);
        ss += xor16f(ss); ss += xor32f(ss);
        const float inv = __builtin_amdgcn_rsqf(ss * (1.f / 96.f) + EPS);
        const f32x4 g0 = *(const f32x4*)(gk + 8 * fq), g1 = *(const f32x4*)(gk + 8 * fq + 4), g2 = *(const f32x4*)(gk + 32 + 8 * fq), g3 = *(const f32x4*)(gk + 32 + 8 * fq + 4);
        const f32x4 gr1 = *(const f32x4*)(gk + 64 + 4 * fq), gr2 = *(const f32x4*)(gk + 80 + 4 * fq);
        bf16_t* dst = Kb + ((size_t)(b * NH + h) * LP + p) * 96;
        *(u32x4*)(dst + 8 * fq) = pack8(v0 * inv * g0, v1 * inv * g1);
        *(u32x4*)(dst + 32 + 8 * fq) = pack8(v2 * inv * g2, v3 * inv * g3);
        const f32x4 y1 = x1 * inv * gr1, y2 = x2 * inv * gr2;
        const f32x4 o1 = y1 * d.cs - y2 * d.sn, o2 = y2 * d.cs + y1 * d.sn;
        u32x2 w1, w2; w1.x = cvt_pk_bf16(o1[0], o1[1]); w1.y = cvt_pk_bf16(o1[2], o1[3]); w2.x = cvt_pk_bf16(o2[0], o2[1]); w2.y = cvt_pk_bf16(o2[2], o2[3]);
        *(u32x2*)(dst + 64 + 4 * fq) = w1; *(u32x2*)(dst + 80 + 4 * fq) = w2;
    }
};
struct FPoolUp {
    bf16_t* proj;
    struct Ld { u32x4 g0, g1; };
    __device__ __forceinline__ void load(Ld& d, int row, int c0, int, int) const { d.g0 = *(const u32x4*)(proj + (size_t)row * PW + C_GP + c0); d.g1 = *(const u32x4*)(proj + (size_t)row * PW + C_GP + c0 + 128); }
    __device__ __forceinline__ void half(const u32x4& gw, int row, int col, const f32x4& a, const f32x4& b) const {
        float g[8]; unpack8(gw, g);
        f32x4 r0, r1;
#pragma unroll
        for (int i = 0; i < 4; ++i) { r0[i] = a[i] * sigmoidf_(g[i]); r1[i] = b[i] * sigmoidf_(g[4 + i]); }
        *(u32x4*)(proj + (size_t)row * PW + C_MPOOL + col) = pack8(r0, r1);
    }
    __device__ __forceinline__ void apply(const Ld& d, int row, int c0, int, int, int, const f32x4& a0, const f32x4& b0, const f32x4& a1, const f32x4& b1) const { half(d.g0, row, c0, a0, b0); half(d.g1, row, c0 + 128, a1, b1); }
};
struct FMlaUp {
    const bf16_t* proj; bf16_t* merged;
    struct Ld { u32x4 g0, g1, p0, p1; };
    __device__ __forceinline__ void load(Ld& d, int row, int c0, int, int) const {
        d.g0 = *(const u32x4*)(proj + (size_t)row * PW + C_GM + c0); d.g1 = *(const u32x4*)(proj + (size_t)row * PW + C_GM + c0 + 128);
        d.p0 = *(const u32x4*)(proj + (size_t)row * PW + C_MPOOL + c0); d.p1 = *(const u32x4*)(proj + (size_t)row * PW + C_MPOOL + c0 + 128); }
    __device__ __forceinline__ void half(const u32x4& gw, const u32x4& pw, int row, int col, const f32x4& a, const f32x4& b) const {
        float g[8]; unpack8(gw, g); float p[8]; unpack8(pw, p);
        f32x4 r0, r1;
#pragma unroll
        for (int i = 0; i < 4; ++i) { r0[i] = a[i] * sigmoidf_(g[i]) + p[i]; r1[i] = b[i] * sigmoidf_(g[4 + i]) + p[4 + i]; }
        *(u32x4*)(merged + (size_t)row * 1024 + col) = pack8(r0, r1);
    }
    __device__ __forceinline__ void apply(const Ld& d, int row, int c0, int, int, int, const f32x4& a0, const f32x4& b0, const f32x4& a1, const f32x4& b1) const { half(d.g0, d.p0, row, c0, a0, b0); half(d.g1, d.p1, row, c0 + 128, a1, b1); }
};
__device__ __forceinline__ float* hres_row(float* out, float* metah, int row) {
    const int b = row / LP, t = row - b * LP - PADF;
    if (t < 0) return nullptr;
    if (t < NMETA) return metah + (size_t)(b * NMETA + t) * DM;
    return out + ((size_t)b * SEQ + (t - NMETA)) * DM;
}
struct FOut {
    float* out; float* metah; bf16_t* hb; float* ssqh; const float* xin; const float* metain;
    struct Ld { f32x4 v[4]; };
    __device__ __forceinline__ void load(Ld& d, int row, int c0, int, int) const {
        const int b = row / LP, t = row - b * LP - PADF;
        const f32x4 z = (f32x4){0.f, 0.f, 0.f, 0.f}; d.v[0] = z; d.v[1] = z; d.v[2] = z; d.v[3] = z;
        if (t >= 0) { const float* sr = xin ? ((t < NMETA) ? metain + (size_t)t * DM : xin + ((size_t)b * SEQ + (t - NMETA)) * DM) : hres_row(out, metah, row);
            d.v[0] = *(const f32x4*)(sr + c0); d.v[1] = *(const f32x4*)(sr + c0 + 4); d.v[2] = *(const f32x4*)(sr + c0 + 128); d.v[3] = *(const f32x4*)(sr + c0 + 132); }
    }
    __device__ __forceinline__ void apply(const Ld& d, int row, int c0, int pn, int wc, int fq, const f32x4& a0, const f32x4& b0, const f32x4& a1, const f32x4& b1) const {
        float* r = hres_row(out, metah, row);
        f32x4 v0 = (f32x4){0.f, 0.f, 0.f, 0.f}, v1 = v0, v2 = v0, v3 = v0;
        if (r) { v0 = d.v[0] + a0; v1 = d.v[1] + b0; v2 = d.v[2] + a1; v3 = d.v[3] + b1;
            *(f32x4*)(r + c0) = v0; *(f32x4*)(r + c0 + 4) = v1; *(f32x4*)(r + c0 + 128) = v2; *(f32x4*)(r + c0 + 132) = v3; }
        if (!hb) return;
        *(u32x4*)(hb + (size_t)row * DM + c0) = pack8(v0, v1); *(u32x4*)(hb + (size_t)row * DM + c0 + 128) = pack8(v2, v3);
        const f32x4 sq = v0 * v0 + v1 * v1 + v2 * v2 + v3 * v3;
        float ss = (sq[0] + sq[1]) + (sq[2] + sq[3]);
        ss += xor16f(ss); ss += xor32f(ss);
        if (fq == 0) ssqh[(size_t)row * 16 + 4 * pn + wc] = ss;
    }
};
enum { K_IN = 0, K_Q = 1, K_KV = 2, K_POOLUP = 3, K_MLAUP = 4, K_OUT = 5, K_VT = 6 };
struct EpiAll {
    int kind; unsigned char* ws; float* out; const float* gk; const float* xin; const float* metain; int last;
    __device__ __forceinline__ void operator()(const f32x4 (&acc)[2][2][4][2], const pg8::Unit& u, int wr, int wc, int fr, int fq) const {
        bf16_t* proj = (bf16_t*)(ws + WS_PROJ);
        switch (kind) {
            case K_IN:     { pg8::Epi<FIn> e{{proj, (bf16_t*)(ws + WS_KROPE), (const float*)(ws + WS_SSQH), (float*)(ws + WS_SSQQ), (float*)(ws + WS_SSQKV)}}; e(acc, u, wr, wc, fr, fq); } break;
            case K_Q:      { pg8::Epi<FQ> e{{(bf16_t*)(ws + WS_QRAW), (const float*)(ws + WS_SSQQ)}}; e(acc, u, wr, wc, fr, fq); } break;
            case K_KV:     { pg8::Epi<FKV> e{{(bf16_t*)(ws + WS_H), (const bf16_t*)(ws + WS_KROPE), (const float*)(ws + WS_ROPE), (const float*)(ws + WS_SSQKV), gk}}; e(acc, u, wr, wc, fr, fq); } break;
            case K_VT: {
                bf16_t* vt = (bf16_t*)(ws + WS_V); const float* ssqkv = (const float*)(ws + WS_SSQKV);
                const int c0 = u.pn * pg8::BM + wc * 32 + 8 * fq; float sc[2][8];
#pragma unroll
                for (int hf = 0; hf < 2; ++hf)
#pragma unroll
                    for (int i = 0; i < 8; ++i) { const f32x4 pp = *(const f32x4*)(ssqkv + (size_t)(c0 + 128 * hf + i) * 4); sc[hf][i] = __builtin_amdgcn_rsqf(((pp[0] + pp[1]) + (pp[2] + pp[3])) * (1.f / 256.f) + EPS); }
#pragma unroll
                for (int ai = 0; ai < 2; ++ai)
#pragma unroll
                    for (int m = 0; m < 4; ++m) { bf16_t* d = vt + (size_t)(u.pm * pg8::BM + ai * pg8::HALF + wr * 64 + m * 16 + fr) * MP + c0;
#pragma unroll
                        for (int hf = 0; hf < 2; ++hf) { f32x4 x = acc[ai][hf][m][0], y = acc[ai][hf][m][1];
#pragma unroll
                            for (int i = 0; i < 4; ++i) { x[i] *= sc[hf][i]; y[i] *= sc[hf][4 + i]; }
                            *(u32x4*)(d + 128 * hf) = pack8(x, y); }
                        asm volatile("" ::: "memory"); }
            } break;
            case K_POOLUP: { pg8::Epi<FPoolUp> e{{proj}}; e(acc, u, wr, wc, fr, fq); } break;
            case K_MLAUP:  { pg8::Epi<FMlaUp> e{{proj, (bf16_t*)(ws + WS_QRAW)}}; e(acc, u, wr, wc, fr, fq); } break;
            default:       { pg8::Epi<FOut> e{{out, (float*)(ws + WS_METAH), last ? nullptr : (bf16_t*)(ws + WS_H), (float*)(ws + WS_SSQH), xin, metain}}; e(acc, u, wr, wc, fr, fq); } break;
        }
    }
};

__device__ __forceinline__ void tr_item(const float* W, int ldw, int k0, int n0, bf16_t* WT, int ldt, int drow0, int dk0, LAS float* scr, int lane, const float* kgain = nullptr) {
#pragma unroll 8
    for (int i = 0; i < 32; ++i) { const int kk = 2 * i + (lane >> 5); float w = W[(size_t)(k0 + kk) * ldw + n0 + (lane & 31)]; if (kgain) w *= kgain[k0 + kk]; scr[kk * 33 + (lane & 31)] = w; }
    LDS_WAIT(); asm volatile("" ::: "memory");
    const int c = lane & 7;
#pragma unroll
    for (int j = 0; j < 4; ++j) { const int n = (lane >> 3) + 8 * j; const LAS float* s = scr + (8 * c) * 33 + n;
        u32x4 o; o.x = cvt_pk_bf16(s[0 * 33], s[1 * 33]); o.y = cvt_pk_bf16(s[2 * 33], s[3 * 33]); o.z = cvt_pk_bf16(s[4 * 33], s[5 * 33]); o.w = cvt_pk_bf16(s[6 * 33], s[7 * 33]);
        *(u32x4*)(WT + (size_t)(drow0 + n) * ldt + dk0 + 8 * c) = o; }
    LDS_WAIT(); asm volatile("" ::: "memory");
}
__device__ __forceinline__ void wcomb_item(const float* w_in, const float* wg, const float* ngain, bf16_t* WinT, int item, int lane) {
    const int g = item >> 8, kb = (item >> 2) & 63, db = item & 3, kk = lane >> 2, dq = lane & 3, k = kb * 16 + kk, d0 = db * 32 + 8 * dq;
    const float* ap = w_in + (size_t)k * DIN + 128 * g; const float* bp = wg + (size_t)g * 128 * 128 + d0;
    f32x4 c0 = (f32x4){0.f, 0.f, 0.f, 0.f}, c1 = c0;
#pragma unroll 4
    for (int cin = 0; cin < 128; ++cin) { const float av = ap[cin]; const f32x4 b0 = *(const f32x4*)(bp + (size_t)cin * 128), b1 = *(const f32x4*)(bp + (size_t)cin * 128 + 4); c0 += b0 * av; c1 += b1 * av; }
    const float gn = ngain[k];
    bf16_t* o = WinT + (size_t)(128 * g + d0) * 1024 + k;
#pragma unroll
    for (int i = 0; i < 4; ++i) { o[(size_t)i * 1024] = (bf16_t)(cvt_pk_bf16(c0[i] * gn, 0.f) & 0xffffu); o[(size_t)(4 + i) * 1024] = (bf16_t)(cvt_pk_bf16(c1[i] * gn, 0.f) & 0xffffu); }
}
constexpr int CW_I_C = 1024, CW_I_IN = 16 * 129, CW_I_Z = 28, CW_FIRST = CW_I_C + CW_I_IN + CW_I_Z;
__device__ __forceinline__ void convert_weights(const Args& a, int l, LAS unsigned char* lds, unsigned* ctr, int wave, int lane, int lo, int hi) {
    LAS float* scr = (LAS float*)(lds + wave * 16384);
    unsigned char* wb = a.ws + WS_W;
    bf16_t* WinT = (bf16_t*)(wb + W_IN); bf16_t* WqT = (bf16_t*)(wb + W_Q); bf16_t* WkvT = (bf16_t*)(wb + W_KV);
    bf16_t* WpuT = (bf16_t*)(wb + W_PU); bf16_t* WmuT = (bf16_t*)(wb + W_MU); bf16_t* WoT = (bf16_t*)(wb + W_O + (size_t)(l & 1) * 1024 * 1024 * 2);
    const float* w_in = a.w_in + (size_t)l * 1024 * DIN; const float* w_g = a.pool_wg + (size_t)l * 4 * 128 * 128; const float* w_pu = a.pool_wu + (size_t)l * 512 * 1024;
    const float* w_qb = a.w_qb + (size_t)l * 768 * 768; const float* w_kvb = a.w_kvb + (size_t)l * 256 * 1024; const float* w_mu = a.mla_wu + (size_t)l * 512 * 1024; const float* w_o = a.w_out + (size_t)l * 1024 * 1024;
    const float* ngain = a.norm_gain + (size_t)l * DM;
    constexpr int I_C = 1024, I_IN = 16 * 129, I_Q = 12 * 24, I_KV = 4 * 32, I_PU = 8 * 32, I_MU = 8 * 32, I_O = 16 * 32;
    constexpr int I_Z = 28; static_assert(I_C == CW_I_C && I_IN == CW_I_IN && I_Z == CW_I_Z, "item map");
    for (;;) {
        int it = 0; if (lane == 0) it = (int)__hip_atomic_fetch_add(ctr, 1u, __ATOMIC_RELAXED, __HIP_MEMORY_SCOPE_AGENT);
        it = __builtin_amdgcn_readfirstlane(it) + lo;
        if (it >= hi) break;
        int r = it;
        if (r < I_C) { wcomb_item(w_in, w_g, ngain, WinT, r, lane); continue; } r -= I_C;
        if (r < I_IN) { const int kb = r / 129, nb = r % 129 + 16, n0 = nb * 32; const int d = (n0 < 2048) ? n0 : (n0 < 2080 ? 4608 : n0 - 32);
            tr_item(w_in, DIN, kb * 64, n0, WinT, 1024, d, kb * 64, scr, lane, ngain); continue; } r -= I_IN;
        if (r < I_Z) { u32x4* z = (u32x4*)(WinT + (size_t)4640 * 1024) + (size_t)r * 1024 + lane; const u32x4 zz = zero4();
#pragma unroll
            for (int i = 0; i < 16; ++i) z[64 * i] = zz;
            continue; } r -= I_Z;
        if (r < I_Q) { const int kb = r / 24, nb = r % 24; tr_item(w_qb, 768, kb * 64, nb * 32, WqT, 768, nb * 32, kb * 64, scr, lane, a.qa_gain + (size_t)l * 768); continue; } r -= I_Q;
        if (r < I_KV) { const int kb = r / 32, nb = r % 32, h = nb >> 2, q = nb & 3;
            const int d = (q < 2) ? 256 * (h >> 2) + 128 * q + 32 * (h & 3) : 512 + h * 64 + 32 * (q - 2);
            tr_item(w_kvb, 1024, kb * 64, nb * 32, WkvT, 256, d, kb * 64, scr, lane, a.kva_gain + (size_t)l * 256); continue; } r -= I_KV;
        if (r < I_PU) { const int kb = r / 32, nb = r % 32; tr_item(w_pu, 1024, kb * 64, nb * 32, WpuT, 512, nb * 32, kb * 64, scr, lane); continue; } r -= I_PU;
        if (r < I_MU) { const int kb = r / 32, nb = r % 32; tr_item(w_mu, 1024, kb * 64, nb * 32, WmuT, 512, nb * 32, kb * 64, scr, lane); continue; } r -= I_MU;
        { const int kb = r / 32, nb = r % 32; tr_item(w_o, 1024, kb * 64, nb * 32, WoT, 1024, nb * 32, kb * 64, scr, lane); }
    }
}

constexpr int CW_NITEMS = CW_FIRST + 12 * 24 + 4 * 32 + 8 * 32 + 8 * 32 + 16 * 32;
__device__ __forceinline__ void row_to_hb(const float* src, bf16_t* dst, float* ssq16, int lane) {
    unsigned long long* o8 = (unsigned long long*)dst + lane;
    float s = 0.f;
    if (!src) {
#pragma unroll
        for (int j = 0; j < 4; ++j) o8[64 * j] = 0ull;
    } else {
        const f32x4* xr = (const f32x4*)src + lane;
#pragma unroll
        for (int j = 0; j < 4; ++j) { const f32x4 v = xr[64 * j]; s += (v.x * v.x + v.y * v.y) + (v.z * v.z + v.w * v.w);
            o8[64 * j] = (unsigned long long)cvt_pk_bf16(v.x, v.y) | ((unsigned long long)cvt_pk_bf16(v.z, v.w) << 32); }
        s = wave_sum(s);
    }
    if (lane < 16) ssq16[lane] = (lane == 0) ? s : 0.f;
}

__constant__ double c_inv_freq[16] = {1.0, 0.5623413251903491, 0.31622776601683794, 0.1778279410038923, 0.1, 0.05623413251903491, 0.03162277660168379, 0.01778279410038923,
                                       0.01, 0.005623413251903491, 0.0031622776601683794, 0.0017782794100389228, 0.001, 0.0005623413251903491, 0.00031622776601683794, 0.00017782794100389227};
__device__ __forceinline__ void sincos_d(double ang, float& c, float& s) {
    const double k = rint(ang * 0.6366197723675814); const double y = fma(-k, 6.123233995736766e-17, fma(-k, 1.5707963267948966, ang));
    const double y2 = y * y;
    const double sn = y * (1.0 - y2 / 6.0 * (1.0 - y2 / 20.0 * (1.0 - y2 / 42.0 * (1.0 - y2 / 72.0 * (1.0 - y2 / 110.0 * (1.0 - y2 / 156.0))))));
    const double cs = 1.0 - y2 / 2.0 * (1.0 - y2 / 12.0 * (1.0 - y2 / 30.0 * (1.0 - y2 / 56.0 * (1.0 - y2 / 90.0 * (1.0 - y2 / 132.0 * (1.0 - y2 / 182.0))))));
    const int q = ((int)(long long)k) & 3;
    const double cc = (q == 0) ? cs : (q == 1) ? -sn : (q == 2) ? -cs : sn;
    const double ss = (q == 0) ? sn : (q == 1) ? cs : (q == 2) ? -sn : -cs;
    c = (float)cc; s = (float)ss;
}

__device__ __forceinline__ void phase_init(const Args& a, LAS unsigned char* lds, int vcu, int NGW, int wv) {
    const int tid = opaque_tid(wv), lane = tid & 63, wave = __builtin_amdgcn_readfirstlane(tid >> 6), gw = vcu * 8 + wave;
    bf16_t* H = (bf16_t*)(a.ws + WS_H); float* metah = (float*)(a.ws + WS_METAH); float* rope = (float*)(a.ws + WS_ROPE);
    for (int m0 = gw; m0 < MP; m0 += 2 * NGW) {
        f32x4 v[2][4]; const float* srcs[2];
#pragma unroll
        for (int k = 0; k < 2; ++k) { const int m = m0 + k * NGW; srcs[k] = nullptr;
            if (m < MP) { const int b = m / LP, t = m - b * LP - PADF;
                srcs[k] = (t < 0) ? nullptr : (t < NMETA ? a.meta + (size_t)t * DM : a.x + ((size_t)b * SEQ + (t - NMETA)) * DM); }
            if (srcs[k]) {
#pragma unroll
                for (int j = 0; j < 4; ++j) v[k][j] = ((const f32x4*)srcs[k] + lane)[64 * j]; }
            else {
#pragma unroll
                for (int j = 0; j < 4; ++j) v[k][j] = (f32x4){0.f, 0.f, 0.f, 0.f}; } }
#pragma unroll
        for (int k = 0; k < 2; ++k) { const int m = m0 + k * NGW; if (m >= MP) break;
            const int b = m / LP, t = m - b * LP - PADF;
            unsigned long long* o8 = (unsigned long long*)(H + (size_t)m * DM) + lane; float ssum = 0.f;
#pragma unroll
            for (int j = 0; j < 4; ++j) { const f32x4 x = v[k][j]; ssum += (x.x * x.x + x.y * x.y) + (x.z * x.z + x.w * x.w);
                o8[64 * j] = (unsigned long long)cvt_pk_bf16(x.x, x.y) | ((unsigned long long)cvt_pk_bf16(x.z, x.w) << 32); }
            ssum = wave_sum(ssum);
            if (lane < 16) ((float*)(a.ws + WS_SSQH) + (size_t)m * 16)[lane] = (lane == 0) ? ssum : 0.f;
            if (lane < 16) {
                float c = 1.f, sn = 0.f;
                if (t >= 0) { const int p = (t < NMETA) ? t : a.pos[b * SEQ + (t - NMETA)] + NMETA; sincos_d((double)p * c_inv_freq[lane], c, sn); }
                rope[(size_t)m * 32 + lane] = c; rope[(size_t)m * 32 + 16 + lane] = sn;
            }
        }
    }
    convert_weights(a, 0, lds, (unsigned*)(a.ws + WS_CTL) + 8192, wave, lane, 0, CW_FIRST);
}

__device__ __forceinline__ void phase_pool(const Args& a, int l, int vcu, int NGW, int wv) {
    const int tid = opaque_tid(wv), lane = tid & 63, wave = __builtin_amdgcn_readfirstlane(tid >> 6), gw = vcu * 8 + wave;
    bf16_t* proj = (bf16_t*)(a.ws + WS_PROJ);
    const float* sc = a.pool_scale + (size_t)l * 512 + 8 * lane;
    const f32x4 sc0 = *(const f32x4*)sc, sc1 = *(const f32x4*)(sc + 4);
    const int g = lane >> 4, w = 2 << g;
    constexpr int CR = 17, CPB = (LP + CR - 1) / CR;
    for (int ch = gw; ch < BATCH * CPB; ch += NGW) {
        const int bb = ch / CPB, p0 = (ch - bb * CPB) * CR, r0 = bb * LP + p0, nrows = (LP - p0 < CR) ? LP - p0 : CR;
        if (p0 + CR <= PADF) {
            const u32x4 zz = zero4();
            for (int i = 0; i < nrows; ++i) *(u32x4*)(proj + (size_t)(r0 + i) * PW + C_P1Y + 8 * lane) = zz;
            continue; }
        float S[8];
#pragma unroll
        for (int i = 0; i < 8; ++i) S[i] = 0.f;
        for (int j = 1; j < w; ++j) { const u32x4 uw = *(const u32x4*)(proj + (size_t)(r0 - j) * PW + C_U + 8 * lane); float u[8]; unpack8(uw, u);
#pragma unroll
            for (int i = 0; i < 8; ++i) S[i] += u[i]; }
#pragma unroll 2
        for (int i = 0; i < nrows; ++i) {
            const int m = r0 + i, t = p0 + i - PADF;
            bf16_t* prow = proj + (size_t)m * PW;
            const u32x4 uw = *(const u32x4*)(prow + C_U + 8 * lane); float u[8]; unpack8(uw, u);
            const u32x4 zw = *(const u32x4*)(prow + C_Z + 8 * lane); float z[8]; unpack8(zw, z);
            const u32x4 ow = *(const u32x4*)(proj + (size_t)(m - (w - 1)) * PW + C_U + 8 * lane); float o[8]; unpack8(ow, o);
#pragma unroll
            for (int k = 0; k < 8; ++k) S[k] += u[k];
            f32x4 r0v = (f32x4){0.f, 0.f, 0.f, 0.f}, r1v = r0v;
            if (t >= 0) { const int cnt = (t + 1 < w) ? (t + 1) : w; const float ic = 1.0f / (float)cnt;
#pragma unroll
                for (int k = 0; k < 4; ++k) { r0v[k] = (S[k] * ic - u[k]) * sc0[k] * siluf_(z[k]); r1v[k] = (S[4 + k] * ic - u[4 + k]) * sc1[k] * siluf_(z[4 + k]); } }
            *(u32x4*)(prow + C_P1Y + 8 * lane) = pack8(r0v, r1v);
#pragma unroll
            for (int k = 0; k < 8; ++k) S[k] -= o[k];
        }
    }
}

constexpr int KPITCH = 208, VPITCH = 144, KBUF = 64 * KPITCH, VBUF = 64 * VPITCH;
constexpr float QSCALE = 0.1472444460259031f;
constexpr float MASKV = -1e30f;
__device__ __forceinline__ int kvmap(int r, int hi) { return 8 * hi + r + ((r >= 8) ? 8 : 0); }

__device__ __forceinline__ void attn_unit(const Args& a, int l, int b, int h, int R0, bool special, LAS unsigned char* lds, float kb, int wv) {
    const int tid = opaque_tid(wv), lane = tid & 63, wave = __builtin_amdgcn_readfirstlane(tid >> 6), r32 = lane & 31, hi = lane >> 5;
    const bf16_t* qraw = (const bf16_t*)(a.ws + WS_QRAW); const bf16_t* Kb = (const bf16_t*)(a.ws + WS_H); const bf16_t* Vb = (const bf16_t*)(a.ws + WS_V);
    const float* rope = (const float*)(a.ws + WS_ROPE); bf16_t* proj = (bf16_t*)(a.ws + WS_PROJ);
    const float* gq = a.qn_gain + (size_t)l * 96;
    const int qp = R0 + 32 * wave + r32;
    const int mq = b * LP + qp;
    const int TL = special ? 1 : (R0 + 255) / 64;
    const int qmin = R0 + 32 * wave;
    const int tw = (qmin + 31) / 64 < TL ? (qmin + 31) / 64 : TL;
    const bf16_t* Kh = Kb + (size_t)(b * NH + h) * LP * 96;
    LAS unsigned char* KB0 = lds; LAS unsigned char* VB0 = lds + 4 * KBUF;
    int kofs[2], vofs[2];
#pragma unroll
    for (int i = 0; i < 2; ++i) { const int ck = (wave + 8 * i) * 64 + lane, rk = ck / 13, qk = ck - rk * 13; kofs[i] = rk * 96 + (qk < 12 ? qk : 11) * 8;
        const int cv = (i == 0 ? wave : 8) * 64 + lane, rv = cv / 9, qv = cv - rv * 9; vofs[i] = rv * MP + (qv < 8 ? qv : 7) * 8; }
    const bf16_t* Vh = Vb + (size_t)(h * 64) * MP + (size_t)b * LP;
    const int nis = 2 + (wave < 5 ? 1 : 0) + (wave == 0 ? 1 : 0);
#define ATT_DMAK(t) do { const bf16_t* kt = Kh + (size_t)(t) * 64 * 96; LAS unsigned char* kb = KB0 + ((t) & 3) * KBUF; \
        __builtin_amdgcn_global_load_lds((const unsigned*)(kt + kofs[0]), (LAS unsigned*)(kb + wave * 1024), 16, 0, 0); \
        if (wave < 5) __builtin_amdgcn_global_load_lds((const unsigned*)(kt + kofs[1]), (LAS unsigned*)(kb + (wave + 8) * 1024), 16, 0, 0); } while (0)
#define ATT_DMAV(t) do { const bf16_t* vt = Vh + (t) * 64; LAS unsigned char* vb = VB0 + ((t) % 3) * VBUF; \
        __builtin_amdgcn_global_load_lds((const unsigned*)(vt + vofs[0]), (LAS unsigned*)(vb + wave * 1024), 16, 0, 0); \
        if (wave == 0) __builtin_amdgcn_global_load_lds((const unsigned*)(vt + vofs[1]), (LAS unsigned*)(vb + 8 * 1024), 16, 0, 0); } while (0)
    LAS unsigned char* QST = lds + 81920 + wave * 6144;
    LAS unsigned char* RST = (wave < 3) ? lds + wave * 4096 : (wave < 6) ? lds + 3 * KBUF + (wave - 3) * 4096 : lds + 4 * KBUF + (wave - 6) * 4096;
    { const int mq0 = b * LP + R0 + 32 * wave;
#pragma unroll
      for (int j = 0; j < 6; ++j) { const int c = j * 64 + lane, row = c / 12, piece = c - row * 12;
          __builtin_amdgcn_global_load_lds((const unsigned*)(qraw + (size_t)(mq0 + row) * 768 + h * 96 + piece * 8), (LAS unsigned*)(QST + j * 1024), 16, 0, 0); }
#pragma unroll
      for (int j = 0; j < 4; ++j)
          __builtin_amdgcn_global_load_lds((const unsigned*)(rope + (size_t)mq0 * 32 + (j * 64 + lane) * 4), (LAS unsigned*)(RST + j * 1024), 16, 0, 0); }
    ATT_DMAK(1); ATT_DMAV(1); ATT_DMAK(2);
    if (wave == 0) asm volatile("s_waitcnt vmcnt(6)" ::: "memory"); else if (wave < 5) asm volatile("s_waitcnt vmcnt(5)" ::: "memory"); else asm volatile("s_waitcnt vmcnt(3)" ::: "memory");
    bf16x8 qr[6]; float qnorm = 0.f;
    {
        float qf[6][8]; float ss = 0.f;
        const LAS unsigned char* qs = QST + r32 * 192 + hi * 16;
#pragma unroll
        for (int d0 = 0; d0 < 6; ++d0) { const u32x4 w = *(const LAS u32x4*)(qs + 32 * d0); unpack8(w, qf[d0]);
#pragma unroll
            for (int i = 0; i < 8; ++i) ss += qf[d0][i] * qf[d0][i]; }
        ss += xor32f(ss);
        const float inv = __builtin_amdgcn_rsqf(ss * (1.f / 96.f) + EPS);
#pragma unroll
        for (int d0 = 0; d0 < 6; ++d0) { const f32x4 g0 = *(const f32x4*)(gq + 16 * d0 + 8 * hi), g1 = *(const f32x4*)(gq + 16 * d0 + 8 * hi + 4);
#pragma unroll
            for (int i = 0; i < 4; ++i) { qf[d0][i] *= inv * g0[i]; qf[d0][4 + i] *= inv * g1[i]; } }
        const LAS unsigned char* cs = RST + r32 * 128 + hi * 32;
        const f32x4 c0 = *(const LAS f32x4*)(cs), c1 = *(const LAS f32x4*)(cs + 16), s0 = *(const LAS f32x4*)(cs + 64), s1 = *(const LAS f32x4*)(cs + 80);
#pragma unroll
        for (int i = 0; i < 8; ++i) { const float c = (i < 4) ? c0[i & 3] : c1[i & 3], s = (i < 4) ? s0[i & 3] : s1[i & 3]; const float x1 = qf[4][i], x2 = qf[5][i];
            qf[4][i] = x1 * c - x2 * s; qf[5][i] = x2 * c + x1 * s; }
        { float q2 = 0.f;
#pragma unroll
          for (int d0 = 0; d0 < 6; ++d0)
#pragma unroll
              for (int i = 0; i < 8; ++i) q2 += qf[d0][i] * qf[d0][i];
          q2 += xor32f(q2); qnorm = __builtin_amdgcn_sqrtf(q2) * QSCALE; }
#pragma unroll
        for (int d0 = 0; d0 < 6; ++d0) { u32x4 w; w.x = cvt_pk_bf16(qf[d0][0] * QSCALE, qf[d0][1] * QSCALE); w.y = cvt_pk_bf16(qf[d0][2] * QSCALE, qf[d0][3] * QSCALE);
            w.z = cvt_pk_bf16(qf[d0][4] * QSCALE, qf[d0][5] * QSCALE); w.w = cvt_pk_bf16(qf[d0][6] * QSCALE, qf[d0][7] * QSCALE); qr[d0] = __builtin_bit_cast(bf16x8, w); }
    }
    asm volatile("s_waitcnt vmcnt(0) lgkmcnt(0)" ::: "memory"); __builtin_amdgcn_s_barrier(); asm volatile("" ::: "memory");
    ATT_DMAK(3); ATT_DMAV(2);
    const int krow = kvmap((r32 & 3) + 4 * (r32 >> 3), (r32 >> 2) & 1);
    const int koff = krow * KPITCH + 16 * hi, voff = r32 * VPITCH + 16 * hi;
#define ATT_QK(P0, P1, t, C) do { const LAS unsigned char* kb = KB0 + ((t) & 3) * KBUF + koff; P0 = C; P1 = C; \
        _Pragma("unroll") for (int d0 = 0; d0 < 6; ++d0) { const bf16x8 ka = *(const LAS bf16x8*)(kb + 32 * d0), kc = *(const LAS bf16x8*)(kb + 32 * KPITCH + 32 * d0); \
            P0 = __builtin_amdgcn_mfma_f32_32x32x16_bf16(ka, qr[d0], P0, 0, 0, 0); P1 = __builtin_amdgcn_mfma_f32_32x32x16_bf16(kc, qr[d0], P1, 0, 0, 0); } } while (0)
#define ATT_MASK(P0, P1, t, PADCHK) do { _Pragma("unroll") for (int r = 0; r < 16; ++r) { const int kv = 64 * (t) + kvmap(r, hi); \
        if (!(kv <= qp && (!(PADCHK) || kv >= PADF))) P0[r] = MASKV; if (!(kv + 32 <= qp && (!(PADCHK) || kv + 32 >= PADF))) P1[r] = MASKV; } } while (0)
#define ATT_ROWMAX(P0, P1, RM) do { float a_ = fmaxf(fmaxf(P0[0], P0[1]), P1[0]), b_ = fmaxf(fmaxf(P0[2], P0[3]), P1[1]); a_ = fmaxf(fmaxf(a_, P1[2]), P1[3]); \
        _Pragma("unroll") for (int r = 4; r < 16; r += 4) { a_ = fmaxf(fmaxf(a_, P0[r]), P0[r + 1]); b_ = fmaxf(fmaxf(b_, P0[r + 2]), P0[r + 3]); a_ = fmaxf(fmaxf(a_, P1[r]), P1[r + 1]); b_ = fmaxf(fmaxf(b_, P1[r + 2]), P1[r + 3]); } \
        RM = fmaxf(a_, b_); RM = fmaxf(RM, xor32f(RM)); } while (0)
    const bool fixed = kb > 0.f;
    float mref = fixed ? kb * qnorm : 0.f, lsum = 0.f; f32x16 o0 = {}, o1 = {}, pc0 = {}, pc1 = {}, negm;
#pragma unroll
    for (int r = 0; r < 16; ++r) negm[r] = -mref;
    if (tw >= 1) {
        ATT_QK(pc0, pc1, 1, negm);
        ATT_MASK(pc0, pc1, 1, true);
        if (!fixed) {
            float rm; ATT_ROWMAX(pc0, pc1, rm);
            mref = (rm < -1e29f) ? 0.f : rm;
#pragma unroll
            for (int r = 0; r < 16; ++r) { pc0[r] -= mref; pc1[r] -= mref; negm[r] = -mref; }
        }
    }
#define ATT_EXPP(pc0, pc1) do { float ps = 0.f; \
        _Pragma("unroll") for (int r = 0; r < 16; ++r) { pc0[r] = __builtin_amdgcn_exp2f(pc0[r]); pc1[r] = __builtin_amdgcn_exp2f(pc1[r]); ps += pc0[r] + pc1[r]; } \
        lsum += ps; \
        { u32x4 w; w.x = cvtpk_s(pc0[0], pc0[1]); w.y = cvtpk_s(pc0[2], pc0[3]); w.z = cvtpk_s(pc0[4], pc0[5]); w.w = cvtpk_s(pc0[6], pc0[7]); pa[0] = __builtin_bit_cast(bf16x8, w); \
          w.x = cvtpk_s(pc0[8], pc0[9]); w.y = cvtpk_s(pc0[10], pc0[11]); w.z = cvtpk_s(pc0[12], pc0[13]); w.w = cvtpk_s(pc0[14], pc0[15]); pa[1] = __builtin_bit_cast(bf16x8, w); \
          w.x = cvtpk_s(pc1[0], pc1[1]); w.y = cvtpk_s(pc1[2], pc1[3]); w.z = cvtpk_s(pc1[4], pc1[5]); w.w = cvtpk_s(pc1[6], pc1[7]); pa[2] = __builtin_bit_cast(bf16x8, w); \
          w.x = cvtpk_s(pc1[8], pc1[9]); w.y = cvtpk_s(pc1[10], pc1[11]); w.z = cvtpk_s(pc1[12], pc1[13]); w.w = cvtpk_s(pc1[14], pc1[15]); pa[3] = __builtin_bit_cast(bf16x8, w); } } while (0)
#define ATT_EXP() ATT_EXPP(pc0, pc1)
#define ATT_LDV(t) do { const LAS unsigned char* vb = VB0 + ((t) % 3) * VBUF + voff; \
        _Pragma("unroll") for (int k = 0; k < 4; ++k) { vf[2 * k] = *(const LAS bf16x8*)(vb + 32 * k); vf[2 * k + 1] = *(const LAS bf16x8*)(vb + 32 * VPITCH + 32 * k); } } while (0)
#define ATT_PV() do { _Pragma("unroll") for (int k = 0; k < 4; ++k) { o0 = __builtin_amdgcn_mfma_f32_32x32x16_bf16(vf[2 * k], pa[k], o0, 0, 0, 0); o1 = __builtin_amdgcn_mfma_f32_32x32x16_bf16(vf[2 * k + 1], pa[k], o1, 0, 0, 0); } } while (0)
    if (wave >= 4) __builtin_amdgcn_s_setprio(1);
#define ATT_ISSUE(t) do { if ((t) + 3 <= TL) ATT_DMAK((t) + 3); if ((t) + 2 <= TL) ATT_DMAV((t) + 2); } while (0)
#define ATT_SYNC(t) do { if ((t) + 3 <= TL) { if (nis == 4) asm volatile("s_waitcnt vmcnt(4)" ::: "memory"); else if (nis == 3) asm volatile("s_waitcnt vmcnt(3)" ::: "memory"); else asm volatile("s_waitcnt vmcnt(2)" ::: "memory"); } \
        else asm volatile("s_waitcnt vmcnt(0)" ::: "memory"); \
        LDS_WAIT(); __builtin_amdgcn_s_barrier(); asm volatile("" ::: "memory"); } while (0)
#define ATT_BODY(t, C0, C1, N0, N1) do { ATT_ISSUE(t); \
        bf16x8 vf[8], pa[4]; \
        { const LAS unsigned char* kb_ = KB0 + (((t) + 1) & 3) * KBUF + koff; bf16x8 kf[6]; \
          _Pragma("unroll") for (int d0 = 0; d0 < 3; ++d0) { kf[2 * d0] = *(const LAS bf16x8*)(kb_ + 32 * d0); kf[2 * d0 + 1] = *(const LAS bf16x8*)(kb_ + 32 * KPITCH + 32 * d0); } \
          N0 = __builtin_amdgcn_mfma_f32_32x32x16_bf16(kf[0], qr[0], negm, 0, 0, 0); N1 = __builtin_amdgcn_mfma_f32_32x32x16_bf16(kf[1], qr[0], negm, 0, 0, 0); \
          _Pragma("unroll") for (int d0 = 1; d0 < 3; ++d0) { N0 = __builtin_amdgcn_mfma_f32_32x32x16_bf16(kf[2 * d0], qr[d0], N0, 0, 0, 0); N1 = __builtin_amdgcn_mfma_f32_32x32x16_bf16(kf[2 * d0 + 1], qr[d0], N1, 0, 0, 0); } \
          __builtin_amdgcn_sched_barrier(0); \
          _Pragma("unroll") for (int d0 = 3; d0 < 6; ++d0) { kf[2 * (d0 - 3)] = *(const LAS bf16x8*)(kb_ + 32 * d0); kf[2 * (d0 - 3) + 1] = *(const LAS bf16x8*)(kb_ + 32 * KPITCH + 32 * d0); } \
          _Pragma("unroll") for (int d0 = 3; d0 < 6; ++d0) { N0 = __builtin_amdgcn_mfma_f32_32x32x16_bf16(kf[2 * (d0 - 3)], qr[d0], N0, 0, 0, 0); N1 = __builtin_amdgcn_mfma_f32_32x32x16_bf16(kf[2 * (d0 - 3) + 1], qr[d0], N1, 0, 0, 0); } } \
        ATT_LDV(t); ATT_EXPP(C0, C1); ATT_PV(); \
        if (64 * ((t) + 1) + 63 > qmin) ATT_MASK(N0, N1, (t) + 1, false); \
        if (!fixed) { float rm; ATT_ROWMAX(N0, N1, rm); \
            if (__any(rm > 8.f)) { const float d = (rm > 8.f) ? rm : 0.f; const float f = __builtin_amdgcn_exp2f(-d); mref += d; lsum *= f; \
                _Pragma("unroll") for (int r = 0; r < 16; ++r) { N0[r] -= d; N1[r] -= d; negm[r] -= d; o0[r] *= f; o1[r] *= f; } } } \
        ATT_SYNC(t); } while (0)
#define ATT_TAIL(t, C0, C1) do { ATT_ISSUE(t); bf16x8 vf[8], pa[4]; ATT_LDV(t); ATT_EXPP(C0, C1); ATT_PV(); ATT_SYNC(t); } while (0)
    {
        f32x16 pb0, pb1; int t = 1;
        for (; t + 1 < tw; t += 2) { ATT_BODY(t, pc0, pc1, pb0, pb1); ATT_BODY(t + 1, pb0, pb1, pc0, pc1); }
        if (t < tw) { ATT_BODY(t, pc0, pc1, pb0, pb1); ++t; ATT_TAIL(t, pb0, pb1); ++t; }
        else if (t == tw) { ATT_TAIL(t, pc0, pc1); ++t; }
        for (; t <= TL; ++t) { ATT_ISSUE(t); ATT_SYNC(t); }
    }
    __builtin_amdgcn_s_setprio(0);
#undef ATT_ISSUE
#undef ATT_SYNC
#undef ATT_BODY
#undef ATT_TAIL
#undef ATT_EXPP
#undef ATT_EXP
#undef ATT_LDV
#undef ATT_PV
#undef ATT_DMAK
#undef ATT_DMAV
#undef ATT_QK
#undef ATT_MASK
#undef ATT_ROWMAX
    lsum += xor32f(lsum);
    const float il = (lsum > 0.f) ? 1.0f / lsum : 0.f;
    if (!(special && wave >= 4)) {
        bf16_t* prow = proj + (size_t)mq * PW + h * 64 + (hi ? 8 : 0);
#pragma unroll
        for (int db = 0; db < 2; ++db)
#pragma unroll
            for (int gp = 0; gp < 2; ++gp) {
                const f32x16& o = db ? o1 : o0;
                float v[8];
#pragma unroll
                for (int i = 0; i < 4; ++i) {
                    const auto rr = __builtin_amdgcn_permlane32_swap(__float_as_uint(o[8 * gp + i]), __float_as_uint(o[8 * gp + 4 + i]), false, false);
                    v[i] = __uint_as_float(rr[0]); v[4 + i] = __uint_as_float(rr[1]); }
                const int col = 32 * db + 16 * gp;
                const u32x4 zw = *(const u32x4*)(prow + C_ZM + col); float z[8]; unpack8(zw, z);
                f32x4 r0, r1;
#pragma unroll
                for (int i = 0; i < 4; ++i) { r0[i] = v[i] * il * siluf_(z[i]); r1[i] = v[4 + i] * il * siluf_(z[4 + i]); }
                *(u32x4*)(prow + C_OZ + col) = pack8(r0, r1);
            }
    }
}
__device__ __forceinline__ void phase_attn(const Args& a, int l, LAS unsigned char* lds, int vcu, int G, int wv) {
    (void)vcu; (void)G;
    float kb;
    { const float* gq = a.qn_gain + (size_t)l * 96; const float* gk = a.kn_gain + (size_t)l * 96;
      float mq = 0.f, mk = 0.f;
      for (int i = 0; i < 96; ++i) { mq = fmaxf(mq, fabsf(gq[i])); mk = fmaxf(mk, fabsf(gk[i])); }
      kb = 1.01f * 9.7979590f * mk;
      const float hi = kb * 9.7979590f * mq * QSCALE;
      if (!(hi < 48.f)) kb = -1.f; }
    unsigned* ctr = (unsigned*)(a.ws + WS_CTL) + 8192 + 64 * (16 + l);
    volatile LAS unsigned* ticket = (volatile LAS unsigned*)(lds + 131072 + 2048);
    const int tid0 = opaque_tid(wv);
    for (;;) {
        if (tid0 == 0) ticket[0] = __hip_atomic_fetch_add(ctr, 1u, __ATOMIC_RELAXED, __HIP_MEMORY_SCOPE_AGENT);
        LDS_WAIT(); __builtin_amdgcn_s_barrier(); asm volatile("" ::: "memory");
        const int idx = (int)ticket[0];
        if (idx >= 1024 + 32) break;
        int b, h, R0; bool special;
        if (idx < 1024) { const int bh = idx & 31; b = bh >> 3; h = bh & 7; R0 = 128 + 256 * (31 - (idx >> 5)); special = false; }
        else { const int it = idx - 1024; b = it >> 3; h = it & 7; R0 = 0; special = true; }
        attn_unit(a, l, b, h, R0, special, lds, kb, wv);
    }
}

constexpr int NPHASE = 1 + 5 * DEPTH;
__global__ void __launch_bounds__(512, 2) trunk_fwd(Args a0) {
    extern __shared__ __attribute__((aligned(16))) unsigned char lds_raw[];
    LAS unsigned char* lds = (LAS unsigned char*)lds_raw;
    const int G = gridDim.x, bx = blockIdx.x;
    const int wv = __builtin_amdgcn_readfirstlane(threadIdx.x >> 6);
    const int vcu = (G % 8 == 0) ? (bx % 8) * (G / 8) + bx / 8 : bx;
    const int NGW = G * 8;
    for (int u = opaque_tid(wv); u < (LDS_BYTES - 131072) / 4; u += 512) ((LAS unsigned*)(lds + 131072))[u] = 0u;
    __syncthreads();
    XcdBarrier bar = xcd_barrier_post((unsigned*)(a0.ws + WS_CTL) + 4096, (volatile LAS unsigned*)(lds + MISC_OFF) + 8, opaque_tid(wv));
    for (int ph = a0.ph_lo; ph < a0.ph_hi; ++ph) {
        Args a = a0; { size_t off = 0; asm volatile("" : "+s"(off)); a.ws = a0.ws + off; }
        unsigned char* ws = a.ws;
        if (ph == 0) phase_init(a, lds, vcu, NGW, wv);
        else {
            const int l = (ph - 1) / 5, sp = (ph - 1) % 5;
            if (sp == 1) phase_pool(a, l, vcu, NGW, wv);
            else if (sp == 2) phase_attn(a, l, lds, vcu, G, wv);
            for (int j = 0; j < 3; ++j) {
                pg8::Gemm g{nullptr, 0, nullptr, 0, MP, 0, 0, 0};
                EpiAll E{K_IN, ws, a.out, a.kn_gain + (size_t)l * 96, (l == 0) ? a.x : nullptr, a.meta, (l == DEPTH - 1) ? 1 : 0};
                const bf16_t* PROJ = (const bf16_t*)(ws + WS_PROJ); const unsigned char* wb = ws + WS_W;
                if (sp == 0 && j == 0)      { g.A = (const bf16_t*)(ws + WS_H); g.lda = 1024; g.Bt = (const bf16_t*)(wb + W_IN); g.ldb = 1024; g.N = NIN_PAD; g.K = 1024; E.kind = K_IN; }
                else if (sp == 1 && j == 0) { g.A = PROJ + C_CQ; g.lda = PW; g.Bt = (const bf16_t*)(wb + W_Q); g.ldb = 768; g.N = 768; g.K = 768; E.kind = K_Q; }
                else if (sp == 1 && j == 1) { g.A = PROJ + C_CKV; g.lda = PW; g.Bt = (const bf16_t*)(wb + W_KV); g.ldb = 256; g.N = 512; g.K = 256; E.kind = K_KV; }
                else if (sp == 1 && j == 2) { g.A = (const bf16_t*)(wb + W_KV) + 512 * 256; g.lda = 256; g.Bt = PROJ + C_CKV; g.ldb = PW; g.M = 512; g.N = MP; g.K = 256; E.kind = K_VT; }
                else if (sp == 2 && j == 0) { g.A = PROJ + C_P1Y; g.lda = PW; g.Bt = (const bf16_t*)(wb + W_PU); g.ldb = 512; g.N = 1024; g.K = 512; E.kind = K_POOLUP; }
                else if (sp == 3 && j == 0) { g.A = PROJ + C_OZ; g.lda = PW; g.Bt = (const bf16_t*)(wb + W_MU); g.ldb = 512; g.N = 1024; g.K = 512; E.kind = K_MLAUP; }
                else if (sp == 4 && j == 0) { g.A = (const bf16_t*)(ws + WS_QRAW)  ; g.lda = 1024; g.Bt = (const bf16_t*)(wb + W_O) + (size_t)(l & 1) * 1024 * 1024; g.ldb = 1024; g.N = 1024; g.K = 1024; E.kind = K_OUT; }
                else break;
                const int rot = (E.kind == K_KV) ? 134 : (E.kind == K_VT) ? 138 : 0;
                pg8::StaticOrder S; S.init(g.M, g.N, G, (bx + G - rot % G) % G); pg8::gemm_phase(lds, g, S, E, wv);
            }
            if ((sp == 4 && l + 1 < DEPTH) || (sp == 0 && l == 0)) {
                const int tid = opaque_tid(wv), lane = tid & 63, wave = __builtin_amdgcn_readfirstlane(tid >> 6);
                const bool nxt = (sp == 4);
                convert_weights(a, nxt ? l + 1 : 0, lds, (unsigned*)(ws + WS_CTL) + 8192 + 64 * (nxt ? l + 1 : 5), wave, lane, nxt ? 0 : CW_FIRST, CW_NITEMS);
            }
        }
        if (ph + 1 < a0.ph_hi) { if (ph == 0) { __syncthreads(); cg::this_grid().sync(); } else xcd_barrier(bar, opaque_tid(wv)); }
    }
}

extern "C" void kernel_launch(void* const* d_in, const int* in_sizes, int n_in, void* d_out, int out_size, void* d_ws, size_t ws_size, hipStream_t stream) {
    static int grid = 0;
    if (grid == 0) {
        if (n_in != 16 || out_size != BATCH * SEQ * DM || ws_size < WS_END) { fprintf(stderr, "kernel_launch: unexpected shapes (n_in %d out %d ws %zu)\n", n_in, out_size, ws_size); grid = -1; return; }
        int dev = 0, cus = 0, per_cu = 0;
        hipGetDevice(&dev); hipDeviceGetAttribute(&cus, hipDeviceAttributeMultiprocessorCount, dev);
        if (hipFuncSetAttribute((const void*)trunk_fwd, hipFuncAttributeMaxDynamicSharedMemorySize, LDS_BYTES) != hipSuccess) { fprintf(stderr, "kernel_launch: hipFuncSetAttribute failed\n"); grid = -1; return; }
        if (hipOccupancyMaxActiveBlocksPerMultiprocessor(&per_cu, (const void*)trunk_fwd, 512, LDS_BYTES) != hipSuccess || per_cu < 1) { fprintf(stderr, "kernel_launch: occupancy query says %d\n", per_cu); per_cu = 1; }
        (void)hipGetLastError();
        grid = cus * 1;
    }
    if (grid < 0) return;
    Args a{};
    a.x = (const float*)d_in[0]; a.pos = (const int*)d_in[1]; a.meta = (const float*)d_in[2]; a.norm_gain = (const float*)d_in[3]; a.w_in = (const float*)d_in[4];
    a.pool_wg = (const float*)d_in[5]; a.pool_scale = (const float*)d_in[6]; a.pool_wu = (const float*)d_in[7]; a.qa_gain = (const float*)d_in[8]; a.kva_gain = (const float*)d_in[9];
    a.w_qb = (const float*)d_in[10]; a.w_kvb = (const float*)d_in[11]; a.qn_gain = (const float*)d_in[12]; a.kn_gain = (const float*)d_in[13]; a.mla_wu = (const float*)d_in[14]; a.w_out = (const float*)d_in[15];
    a.out = (float*)d_out; a.ws = (unsigned char*)d_ws;
    if (hipMemsetAsync((char*)d_ws + WS_CTL, 0, CTL_ZERO_BYTES, stream) != hipSuccess) { fprintf(stderr, "kernel_launch: memset failed\n"); return; }
#if MK_COOP
    a.ph_lo = 0; a.ph_hi = NPHASE;
    void* args[] = {&a};
    hipError_t e = hipLaunchCooperativeKernel((const void*)trunk_fwd, dim3(grid), dim3(512), args, LDS_BYTES, stream);
    if (e != hipSuccess) fprintf(stderr, "cooperative launch failed: %s (grid %d)\n", hipGetErrorString(e), grid);
#else
    for (int ph = 0; ph < NPHASE; ++ph) { a.ph_lo = ph; a.ph_hi = ph + 1; hipLaunchKernelGGL(trunk_fwd, dim3(grid), dim3(512), LDS_BYTES, stream, a); }
#endif
}
```

```cpp
#include <hip/hip_runtime.h>
#include <hip/hip_cooperative_groups.h>
#include <cstdio>
#include <cstdint>
namespace cg = cooperative_groups;

#ifndef MK_COOP
#define MK_COOP 1
#endif

#define LAS __attribute__((address_space(3)))
typedef unsigned short bf16_t;
typedef short bf16x8 __attribute__((ext_vector_type(8)));
typedef float f32x4 __attribute__((ext_vector_type(4)));
typedef float f32x16 __attribute__((ext_vector_type(16)));
typedef unsigned u32x4 __attribute__((ext_vector_type(4)));
typedef unsigned u32x2 __attribute__((ext_vector_type(2)));

constexpr int BATCH = 4, SEQ = 8192, DM = 1024, DEPTH = 4, NMETA = 16;
constexpr int PADF = 112, LP = 8320, MP = BATCH * LP;
constexpr int NH = 8;
constexpr int DIN = 4640;
constexpr float EPS = 1e-6f;
constexpr int PW = 4608;
constexpr int C_U = 0  , C_Z = 512, C_CQ = 1024, C_CKV = 1792, C_ZM = 2048, C_GP = 2560, C_GM = 3584;
constexpr int C_P1Y = 512  , C_MPOOL = 1024  , C_OZ = 0  ;
constexpr int NIN_PAD = 4864;

constexpr size_t MiB = 1u << 20;
constexpr size_t WS_CTL = 0, CTL_ZERO_BYTES = 65536;
constexpr size_t WS_W = 1 * MiB;
constexpr size_t W_IN = 0, W_Q = W_IN + (size_t)NIN_PAD * 1024 * 2, W_KV = W_Q + 768 * 768 * 2, W_G = W_KV + 1024 * 256 * 2,
                 W_PU = W_G + 512 * 256 * 2, W_MU = W_PU + 1024 * 512 * 2, W_O = W_MU + 1024 * 512 * 2  , W_END = W_O + 2 * 1024 * 1024 * 2;
static_assert(W_END <= 18 * MiB, "weights");
constexpr size_t WS_ROPE = 19 * MiB, WS_SSQH = 24 * MiB  , WS_SSQQ = 27 * MiB  , WS_SSQKV = 29 * MiB  ,
                 WS_METAH = 30 * MiB, WS_KROPE = 31 * MiB, WS_H = 34 * MiB  , WS_PROJ = 99 * MiB, WS_QRAW = 392 * MiB  , WS_V = 441 * MiB, WS_END = 474 * MiB;
static_assert(WS_H + (size_t)MP * 1024 * 2 <= WS_PROJ && WS_PROJ + (size_t)MP * PW * 2 <= WS_QRAW && WS_QRAW + (size_t)MP * 768 * 2 <= WS_V && WS_V + (size_t)MP * 512 * 2 <= WS_END && WS_QRAW + (size_t)MP * 1024 * 2 <= WS_END, "ws map");

constexpr int LDS_BYTES = 147456, MISC_OFF = 131072 + 320;

struct Args {
    const float* x; const int* pos; const float* meta; const float* norm_gain; const float* w_in; const float* pool_wg; const float* pool_scale; const float* pool_wu;
    const float* qa_gain; const float* kva_gain; const float* w_qb; const float* w_kvb; const float* qn_gain; const float* kn_gain; const float* mla_wu; const float* w_out;
    float* out; unsigned char* ws; int ph_lo, ph_hi;
};

__device__ __forceinline__ unsigned cvt_pk_bf16(float lo, float hi) { unsigned r; asm volatile("v_cvt_pk_bf16_f32 %0, %1, %2" : "=v"(r) : "v"(lo), "v"(hi)); return r; }
typedef float f32x2_t __attribute__((ext_vector_type(2))); typedef __bf16 bf16x2_t __attribute__((ext_vector_type(2)));
__device__ __forceinline__ unsigned cvtpk_s(float lo, float hi) { f32x2_t v = {lo, hi}; bf16x2_t b = __builtin_convertvector(v, bf16x2_t); return __builtin_bit_cast(unsigned, b); }
__device__ __forceinline__ float bf_lo(unsigned u) { return __uint_as_float(u << 16); }
__device__ __forceinline__ float bf_hi(unsigned u) { return __uint_as_float(u & 0xffff0000u); }
__device__ __forceinline__ float xor32f(float v) { const auto rr = __builtin_amdgcn_permlane32_swap(__float_as_uint(v), __float_as_uint(v), false, false); const unsigned me = __float_as_uint(v); return __uint_as_float(rr[0] == me ? rr[1] : rr[0]); }
__device__ __forceinline__ float xor16f(float v) { return __uint_as_float((unsigned)__builtin_amdgcn_ds_swizzle((int)__float_as_uint(v), 0x401F)); }
template <int M> __device__ __forceinline__ float xorswz(float v) { return __uint_as_float((unsigned)__builtin_amdgcn_ds_swizzle((int)__float_as_uint(v), (M << 10) | 0x1F)); }
__device__ __forceinline__ float wave_sum(float v) {
    v += xorswz<1>(v); v += xorswz<2>(v); v += xorswz<4>(v); v += xorswz<8>(v); v += xorswz<16>(v); v += xor32f(v);
    return v;
}
__device__ __forceinline__ float sigmoidf_(float g) { return __builtin_amdgcn_rcpf(1.f + __expf(-g)); }
__device__ __forceinline__ float siluf_(float z) { return z * sigmoidf_(z); }
#define LDS_WAIT() asm volatile("s_waitcnt lgkmcnt(0)" ::: "memory")
__device__ __forceinline__ u32x4 zero4() { unsigned z = 0u; asm volatile("" : "+v"(z)); return (u32x4){z, z, z, z}; }
__device__ __forceinline__ int opaque_tid(int wv) { int t = wv * 64 + (int)__builtin_amdgcn_mbcnt_hi(~0u, __builtin_amdgcn_mbcnt_lo(~0u, 0u)); asm volatile("" : "+v"(t)); return t; }

#define XB_TMO      128
#define XB_XCNT(j)  (256  + 64 * (j))
#define XB_XSUB(j)  (1280 + 64 * (j))
#define XB_XGEN(j)  (2304 + 64 * (j))
#define XB_TOP      3328
#define XB_TOPGEN   3392
#define XCD_BAR_WORDS 3456
#define XB_SPIN_CAP (1u << 18)

__device__ __forceinline__ unsigned xb_ld(unsigned* p)              { return __hip_atomic_load(p, __ATOMIC_RELAXED, __HIP_MEMORY_SCOPE_AGENT); }
__device__ __forceinline__ unsigned xb_add(unsigned* p, unsigned v) { return __hip_atomic_fetch_add(p, v, __ATOMIC_RELAXED, __HIP_MEMORY_SCOPE_AGENT); }
__device__ __forceinline__ unsigned xb_xcc_id() { return (unsigned)__builtin_amdgcn_s_getreg((3 << 11) | 20) & 0xFu; }
#define XB_SPIN(cond, bar) do { unsigned _sp = 0; while (cond) { __builtin_amdgcn_s_sleep(1); \
    if ((++_sp & 255u) == 0u) { if (xb_ld(&(bar)[XB_TMO])) break; if (_sp > XB_SPIN_CAP) { atomicAdd(&(bar)[XB_TMO], 1u); break; } } } } while (0)

struct XcdBarrier {
    unsigned* bar; unsigned x;
    volatile LAS unsigned* st;
};

__device__ __forceinline__ XcdBarrier xcd_barrier_post(unsigned* bar, volatile LAS unsigned* st, int tid) {
    XcdBarrier b; b.bar = bar; b.x = xb_xcc_id(); b.st = st;
    if (tid == 0) (void)xb_add(&bar[XB_XCNT(b.x)], 1u);
    return b;
}
__device__ __forceinline__ void xcd_barrier_complete(unsigned* bar, unsigned x, unsigned& nloc, unsigned& nx) {
    const unsigned G = gridDim.x * gridDim.y * gridDim.z;
    unsigned sum, cnt, mine, sp = 0u;
    for (;;) {
        sum = 0u; cnt = 0u; mine = 0u;
#pragma unroll
        for (unsigned j = 0; j < 16; ++j) { const unsigned c = xb_ld(&bar[XB_XCNT(j)]); sum += c; cnt += (c > 0u) ? 1u : 0u; mine = (j == x) ? c : mine; }
        if (sum == G) break;
        __builtin_amdgcn_s_sleep(1);
        if ((++sp & 255u) == 0u) { if (xb_ld(&bar[XB_TMO])) break; if (sp > XB_SPIN_CAP) { atomicAdd(&bar[XB_TMO], 1u); break; } }
    }
    nloc = mine > 0u ? mine : 1u; nx = cnt > 0u ? cnt : 1u;
}

__device__ __forceinline__ void xcd_barrier(const XcdBarrier& b, int tid) {
    asm volatile("s_waitcnt vmcnt(0)" ::: "memory");
    __syncthreads();
    if (tid == 0) {
        unsigned* bar = b.bar;
        __builtin_amdgcn_s_waitcnt(0);
        unsigned nloc = b.st[0], nx = b.st[1];
        if (nloc == 0u) { xcd_barrier_complete(bar, b.x, nloc, nx); b.st[0] = nloc; b.st[1] = nx; }
        const unsigned old = xb_add(&bar[XB_XSUB(b.x)], 1u);
        const unsigned gen = old / nloc;
        if (old + 1u == (gen + 1u) * nloc) {
            __builtin_amdgcn_fence(__ATOMIC_RELEASE, "agent");
            asm volatile("s_waitcnt vmcnt(0)" ::: "memory");
            const unsigned og = xb_add(&bar[XB_TOP], 1u);
            const unsigned tg = og / nx;
            if (og + 1u == (tg + 1u) * nx) xb_add(&bar[XB_TOPGEN], 1u);
            else XB_SPIN(xb_ld(&bar[XB_TOPGEN]) == tg, bar);
            __builtin_amdgcn_fence(__ATOMIC_ACQUIRE, "agent");
            xb_add(&bar[XB_XGEN(b.x)], 1u);
            asm volatile("s_waitcnt vmcnt(0)" ::: "memory");
        } else {
            XB_SPIN(xb_ld(&bar[XB_XGEN(b.x)]) == gen, bar);
            __builtin_amdgcn_fence(__ATOMIC_ACQUIRE, "agent");
            asm volatile("s_waitcnt vmcnt(0)" ::: "memory");
        }
    }
    __syncthreads();
}

namespace pg8 {
constexpr int BM = 256, BK = 64, HALF = 128, HTB = HALF * BK * 2, STAGE_BYTES = 8 * HTB, NXCD = 8, WGM = 8;
__host__ __device__ __forceinline__ int lds_byte(int r, int c) { const int st = (r >> 4) * 2 + (c >> 5), rr = r & 15, cc = c & 31, ob = rr * 64 + cc * 2; return st * 1024 + (ob ^ (((ob >> 9) & 1) << 5)); }
__host__ __device__ __forceinline__ void stage_rc(int b, int& R, int& C) { const int st = b / 1024, sb = b % 1024, swz = sb ^ (((sb >> 9) & 1) << 5); R = (st >> 1) * 16 + swz / 64; C = (st & 1) * 32 + (swz % 64) / 2; }
__host__ __device__ __forceinline__ int perm32(int rho) { const int n = rho >> 4, i = rho & 15; return 8 * (i >> 2) + 4 * n + (i & 3); }
struct Unit { int pm, pn; };
struct Gemm { const bf16_t* A; int lda; const bf16_t* Bt; int ldb; int M, N, K; int apn; };
struct StaticOrder {
    int nM, nN, nwg, G, c;
    __device__ void init(int M, int N, int G_, int c_) { nM = M / BM; nN = N / BM; nwg = nM * nN; G = G_; c = c_; }
    __device__ bool next(int i, Unit& u) const {
        const long L = (long)i * G + c; if (L >= nwg) return false;
        int wgid = (int)L; { const int q = nwg / NXCD, r = nwg % NXCD, xcd = wgid % NXCD, off = wgid / NXCD; wgid = (xcd < r ? xcd * (q + 1) : r * (q + 1) + (xcd - r) * q) + off; }
        const int nig = WGM * nN, gid = wgid / nig, fm = gid * WGM, gsz = (nM - fm) < WGM ? (nM - fm) : WGM;
        u.pm = fm + ((wgid % nig) % gsz); u.pn = (wgid % nig) / gsz; return true;
    }
};
template <class F> struct Epi {
    F f;
    __device__ __forceinline__ void operator()(const f32x4 (&acc)[2][2][4][2], const Unit& u, int wr, int wc, int fr, int fq) const {
        const int c0 = u.pn * BM + wc * 32 + 8 * fq;
#pragma unroll
        for (int ai = 0; ai < 2; ++ai)
#pragma unroll
            for (int mp = 0; mp < 4; mp += 2) {
                typename F::Ld ld[2];
#pragma unroll
                for (int m = 0; m < 2; ++m) f.load(ld[m], u.pm * BM + ai * HALF + wr * 64 + (mp + m) * 16 + fr, c0, u.pn, fq);
#pragma unroll
                for (int m = 0; m < 2; ++m) f.apply(ld[m], u.pm * BM + ai * HALF + wr * 64 + (mp + m) * 16 + fr, c0, u.pn, wc, fq, acc[ai][0][mp + m][0], acc[ai][0][mp + m][1], acc[ai][1][mp + m][0], acc[ai][1][mp + m][1]);
            }
    }
};

template <class EpiT>
__device__ __forceinline__ void gemm_phase(LAS unsigned char* lds, const Gemm g, const StaticOrder& S, const EpiT& E, int wv) {
    const int tid = opaque_tid(wv), wid = __builtin_amdgcn_readfirstlane(tid >> 6), lane = tid & 63, wr = wid >> 2, wc = wid & 3, fr = lane & 15, fq = lane >> 4;
    int K = g.K; asm volatile("" : "+s"(K)); const int nt = K / BK;
    unsigned voffA[2], voffB[2];
#pragma unroll
    for (int i = 0; i < 2; ++i) { int R, C; stage_rc(tid * 16 + i * 8192, R, C); const int Rb = (R & ~31) + perm32(R & 31);
        voffA[i] = (unsigned)(R * g.lda + C) * 2u; voffB[i] = (unsigned)(Rb * g.ldb + C) * 2u; }
    const size_t kstep = (size_t)(BK * 2);
    const size_t hA = (size_t)HALF * g.lda * 2, hB = (size_t)HALF * g.ldb * 2;
    const size_t tA = 2 * hA, tB = 2 * hB;
    const unsigned ldsw = (unsigned)wid * 1024u;
    const int aoff = lds_byte(wr * 64 + fr, fq * 8), boff = lds_byte(wc * 32 + fr, fq * 8);
#define PG8_SA(b, h) (((b) * 2 + (h)) * HTB)
#define PG8_SB(b, h) ((4 + (b) * 2 + (h)) * HTB)
#define PG8_STAGE(bufoff, gbase, voff) do { _Pragma("unroll") for (int _i = 0; _i < 2; ++_i) \
        __builtin_amdgcn_global_load_lds((const unsigned*)((const char*)(gbase) + (voff)[_i]), (LAS unsigned*)(lds + (bufoff) + ldsw + _i * 8192), 16, 0, 0); } while (0)
#define PG8_LDA(dst, b, h) do { _Pragma("unroll") for (int m = 0; m < 4; ++m) _Pragma("unroll") for (int k = 0; k < 2; ++k) dst[m][k] = *(const LAS bf16x8*)(lds + PG8_SA(b, h) + aoff + m * 2048 + k * 1024); } while (0)
#define PG8_LDB(dst, b, h) do { _Pragma("unroll") for (int n = 0; n < 2; ++n) _Pragma("unroll") for (int k = 0; k < 2; ++k) dst[n][k] = *(const LAS bf16x8*)(lds + PG8_SB(b, h) + boff + n * 2048 + k * 1024); } while (0)
#define PG8_MMA(ai, bj, At, Bt) do { __builtin_amdgcn_s_setprio(1); _Pragma("unroll") for (int m = 0; m < 4; ++m) _Pragma("unroll") for (int n = 0; n < 2; ++n) _Pragma("unroll") for (int k = 0; k < 2; ++k) \
        acc[ai][bj][m][n] = __builtin_amdgcn_mfma_f32_16x16x32_bf16(Bt[n][k], At[m][k], acc[ai][bj][m][n], 0, 0, 0); __builtin_amdgcn_s_setprio(0); } while (0)
#define PG8_WAIT_V(n) asm volatile("s_waitcnt vmcnt(" #n ")" ::: "memory")
#define PG8_WAIT_L(n) asm volatile("s_waitcnt lgkmcnt(" #n ")" ::: "memory")
#define PG8_BAR __builtin_amdgcn_s_barrier()
#define PG8_SCHED __builtin_amdgcn_sched_barrier(0)
    Unit cur, nxt; int ui = 0;
    if (!S.next(0, cur)) return;
    f32x4 acc[2][2][4][2];
    { float z = 0.f; asm volatile("" : "+v"(z));
#pragma unroll
    for (int a = 0; a < 2; ++a)
#pragma unroll
        for (int b = 0; b < 2; ++b)
#pragma unroll
            for (int m = 0; m < 4; ++m)
#pragma unroll
                for (int n = 0; n < 2; ++n) acc[a][b][m][n] = (f32x4){z, z, z, z}; }
    bf16x8 At[4][2], B0[2][2], B1[2][2];
    const char* cA = (const char*)g.A + (size_t)cur.pm * tA + (size_t)cur.pn * g.apn * 2; const char* cB = (const char*)g.Bt + (size_t)cur.pn * tB;
    PG8_STAGE(PG8_SB(0, 0), cB, voffB); PG8_STAGE(PG8_SB(0, 1), cB + hB, voffB); PG8_STAGE(PG8_SA(0, 0), cA, voffA); PG8_STAGE(PG8_SA(0, 1), cA + hA, voffA);
    if (wr == 1) PG8_BAR;
    PG8_WAIT_V(2); PG8_BAR;
    PG8_STAGE(PG8_SB(1, 0), cB + kstep, voffB); PG8_STAGE(PG8_SA(1, 0), cA + kstep, voffA); PG8_STAGE(PG8_SB(1, 1), cB + hB + kstep, voffB);
    PG8_WAIT_V(6); PG8_BAR;
    for (;;) {
        const bool has_next = S.next(ui + 1, nxt);
        const char* nA = has_next ? (const char*)g.A + (size_t)nxt.pm * tA + (size_t)nxt.pn * g.apn * 2 : cA; const char* nB = has_next ? (const char*)g.Bt + (size_t)nxt.pn * tB : cB;
#pragma unroll 1
        for (int t = 0; t < nt; t += 2) {
            const bool last = (t == nt - 2);
            const char* a1 = cA + (size_t)(t + 1) * kstep;
            const char* a2 = last ? nA : cA + (size_t)(t + 2) * kstep; const char* b2 = last ? nB : cB + (size_t)(t + 2) * kstep;
            const char* a3 = a2 + kstep; const char* b3 = b2 + kstep;
            PG8_LDB(B0, 0, 0); PG8_LDB(B1, 0, 1); PG8_SCHED; PG8_LDA(At, 0, 0); PG8_STAGE(PG8_SA(1, 1), a1 + hA, voffA);
            PG8_WAIT_V(8); PG8_WAIT_L(0); PG8_BAR; PG8_MMA(0, 0, At, B0); PG8_MMA(0, 1, At, B1); PG8_BAR; PG8_SCHED;
            PG8_LDA(At, 0, 1); PG8_STAGE(PG8_SB(0, 0), b2, voffB); PG8_STAGE(PG8_SB(0, 1), b2 + hB, voffB); PG8_STAGE(PG8_SA(0, 0), a2, voffA);
            PG8_WAIT_V(8); PG8_WAIT_L(0); PG8_BAR; PG8_MMA(1, 0, At, B0); PG8_MMA(1, 1, At, B1); PG8_BAR; PG8_SCHED;
            PG8_LDB(B0, 1, 0); PG8_LDB(B1, 1, 1); PG8_SCHED; PG8_LDA(At, 1, 0); PG8_STAGE(PG8_SA(0, 1), a2 + hA, voffA);
            PG8_WAIT_V(8); PG8_WAIT_L(0); PG8_BAR; PG8_MMA(0, 0, At, B0); PG8_MMA(0, 1, At, B1); PG8_BAR; PG8_SCHED;
            PG8_LDA(At, 1, 1); PG8_STAGE(PG8_SB(1, 0), b3, voffB); PG8_STAGE(PG8_SB(1, 1), b3 + hB, voffB); PG8_STAGE(PG8_SA(1, 0), a3, voffA);
            PG8_WAIT_V(8); PG8_WAIT_L(0); PG8_BAR; PG8_MMA(1, 0, At, B0); PG8_MMA(1, 1, At, B1); PG8_BAR; PG8_SCHED;
        }
        if (wr == 0) PG8_BAR;
        E(acc, cur, wr, wc, fr, fq);
        if (!has_next) break;
        { float z = 0.f; asm volatile("" : "+v"(z));
#pragma unroll
        for (int a = 0; a < 2; ++a)
#pragma unroll
            for (int b = 0; b < 2; ++b)
#pragma unroll
                for (int m = 0; m < 4; ++m)
#pragma unroll
                    for (int n = 0; n < 2; ++n) acc[a][b][m][n] = (f32x4){z, z, z, z}; }
        cur = nxt; cA = nA; cB = nB; ++ui;
        if (wr == 1) PG8_BAR;
    }
    PG8_WAIT_V(0);
    PG8_BAR;
#undef PG8_SA
#undef PG8_SB
#undef PG8_STAGE
#undef PG8_LDA
#undef PG8_LDB
#undef PG8_MMA
#undef PG8_WAIT_V
#undef PG8_WAIT_L
#undef PG8_BAR
#undef PG8_SCHED
}
}

__device__ __forceinline__ u32x4 pack8(const f32x4& a, const f32x4& b) { u32x4 w; w.x = cvt_pk_bf16(a[0], a[1]); w.y = cvt_pk_bf16(a[2], a[3]); w.z = cvt_pk_bf16(b[0], b[1]); w.w = cvt_pk_bf16(b[2], b[3]); return w; }
__device__ __forceinline__ void unpack8(const u32x4& w, float (&v)[8]) { v[0] = bf_lo(w.x); v[1] = bf_hi(w.x); v[2] = bf_lo(w.y); v[3] = bf_hi(w.y); v[4] = bf_lo(w.z); v[5] = bf_hi(w.z); v[6] = bf_lo(w.w); v[7] = bf_hi(w.w); }

__device__ __forceinline__ float row_inv16(const float* p16, float invn) {
    const f32x4 a = ((const f32x4*)p16)[0], b = ((const f32x4*)p16)[1], c = ((const f32x4*)p16)[2], d = ((const f32x4*)p16)[3];
    const float s = ((a[0] + a[1]) + (a[2] + a[3])) + ((b[0] + b[1]) + (b[2] + b[3])) + ((c[0] + c[1]) + (c[2] + c[3])) + ((d[0] + d[1]) + (d[2] + d[3]));
    return 1.0f / sqrtf(s * invn + EPS);
}
struct FIn {
    bf16_t* proj; bf16_t* krope; const float* ssqh; float* ssqq; float* ssqkv;
    struct Ld { f32x4 p[4]; };
    __device__ __forceinline__ void load(Ld& d, int row, int, int, int) const {
#pragma unroll
        for (int i = 0; i < 4; ++i) d.p[i] = ((const f32x4*)(ssqh + (size_t)row * 16))[i]; }
    __device__ __forceinline__ void apply(const Ld& d, int row, int c0, int pn, int wc, int fq, const f32x4& a0, const f32x4& b0, const f32x4& a1, const f32x4& b1) const {
        const f32x4 t = (d.p[0] + d.p[1]) + (d.p[2] + d.p[3]);
        const float inv = __builtin_amdgcn_rsqf(((t[0] + t[1]) + (t[2] + t[3])) * (1.f / DM) + EPS);
        const f32x4 v0 = a0 * inv, v1 = b0 * inv, v2 = a1 * inv, v3 = b1 * inv;
        if (pn < 18) { *(u32x4*)(proj + (size_t)row * PW + c0) = pack8(v0, v1); *(u32x4*)(proj + (size_t)row * PW + c0 + 128) = pack8(v2, v3); }
        else if (c0 < 4608 + 32) *(u32x4*)(krope + (size_t)row * 32 + (c0 - 4608)) = pack8(v0, v1);
        if (pn >= 4 && pn < 8) {
            const f32x4 sq = v0 * v0 + v1 * v1 + v2 * v2 + v3 * v3; float ss = (sq[0] + sq[1]) + (sq[2] + sq[3]);
            ss += xor16f(ss); ss += xor32f(ss);
            if (fq == 0) { if (pn < 7) ssqq[(size_t)row * 12 + (pn - 4) * 4 + wc] = ss; else ssqkv[(size_t)row * 4 + wc] = ss; }
        }
    }
};
struct FQ {
    bf16_t* o; const float* ssqq;
    struct Ld { f32x4 p[3]; };
    __device__ __forceinline__ void load(Ld& d, int row, int, int, int) const {
#pragma unroll
        for (int i = 0; i < 3; ++i) d.p[i] = ((const f32x4*)(ssqq + (size_t)row * 12))[i]; }
    __device__ __forceinline__ void apply(const Ld& d, int row, int c0, int, int, int, const f32x4& a0, const f32x4& b0, const f32x4& a1, const f32x4& b1) const {
        const f32x4 t = d.p[0] + d.p[1] + d.p[2];
        const float inv = __builtin_amdgcn_rsqf(((t[0] + t[1]) + (t[2] + t[3])) * (1.f / 768.f) + EPS);
        *(u32x4*)(o + (size_t)row * 768 + c0) = pack8(a0 * inv, b0 * inv); *(u32x4*)(o + (size_t)row * 768 + c0 + 128) = pack8(a1 * inv, b1 * inv); }
};
struct FKV {
    bf16_t* Kb; const bf16_t* krope; const float* rope; const float* ssqkv; const float* gk;
    struct Ld { f32x4 pp, cs, sn; u32x2 r1, r2; };
    __device__ __forceinline__ void load(Ld& d, int row, int, int, int fq) const {
        d.pp = *(const f32x4*)(ssqkv + (size_t)row * 4);
        d.r1 = *(const u32x2*)(krope + (size_t)row * 32 + 4 * fq); d.r2 = *(const u32x2*)(krope + (size_t)row * 32 + 16 + 4 * fq);
        d.cs = *(const f32x4*)(rope + (size_t)row * 32 + 4 * fq); d.sn = *(const f32x4*)(rope + (size_t)row * 32 + 16 + 4 * fq); }
    __device__ __forceinline__ void apply(const Ld& d, int row, int, int pn, int wc, int fq, const f32x4& a0, const f32x4& b0, const f32x4& a1, const f32x4& b1) const {
        const float akv = __builtin_amdgcn_rsqf(((d.pp[0] + d.pp[1]) + (d.pp[2] + d.pp[3])) * (1.f / 256.f) + EPS);
        const f32x4 v0 = a0 * akv, v1 = b0 * akv, v2 = a1 * akv, v3 = b1 * akv;
        const int h = 4 * pn + wc, b = row / LP, p = row - b * LP;
        const f32x4 x1 = (f32x4){bf_lo(d.r1.x), bf_hi(d.r1.x), bf_lo(d.r1.y), bf_hi(d.r1.y)}, x2 = (f32x4){bf_lo(d.r2.x), bf_hi(d.r2.x), bf_lo(d.r2.y), bf_hi(d.r2.y)};
        const f32x4 sq = v0 * v0 + v1 * v1 + v2 * v2 + v3 * v3 + x1 * x1 + x2 * x2;
        float ss = (sq[0] + sq[1]) + (sq[2] + sq[3]);
        ss += xor16f(ss); ss += xor32f(ss);
        const float inv = __builtin_amdgcn_rsqf(ss * (1.f / 96.f) + EPS);
        const f32x4 g0 = *(const f32x4*)(gk + 8 * fq), g1 = *(const f32x4*)(gk + 8 * fq + 4), g2 = *(const f32x4*)(gk + 32 + 8 * fq), g3 = *(const f32x4*)(gk + 32 + 8 * fq + 4);
        const f32x4 gr1 = *(const f32x4*)(gk + 64 + 4 * fq), gr2 = *(const f32x4*)(gk + 80 + 4 * fq);
        bf16_t* dst = Kb + ((size_t)(b * NH + h) * LP + p) * 96;
        *(u32x4*)(dst + 8 * fq) = pack8(v0 * inv * g0, v1 * inv * g1);
        *(u32x4*)(dst + 32 + 8 * fq) = pack8(v2 * inv * g2, v3 * inv * g3);
        const f32x4 y1 = x1 * inv * gr1, y2 = x2 * inv * gr2;
        const f32x4 o1 = y1 * d.cs - y2 * d.sn, o2 = y2 * d.cs + y1 * d.sn;
        u32x2 w1, w2; w1.x = cvt_pk_bf16(o1[0], o1[1]); w1.y = cvt_pk_bf16(o1[2], o1[3]); w2.x = cvt_pk_bf16(o2[0], o2[1]); w2.y = cvt_pk_bf16(o2[2], o2[3]);
        *(u32x2*)(dst + 64 + 4 * fq) = w1; *(u32x2*)(dst + 80 + 4 * fq) = w2;
    }
};
struct FPoolUp {
    bf16_t* proj;
    struct Ld { u32x4 g0, g1; };
    __device__ __forceinline__ void load(Ld& d, int row, int c0, int, int) const { d.g0 = *(const u32x4*)(proj + (size_t)row * PW + C_GP + c0); d.g1 = *(const u32x4*)(proj + (size_t)row * PW + C_GP + c0 + 128); }
    __device__ __forceinline__ void half(const u32x4& gw, int row, int col, const f32x4& a, const f32x4& b) const {
        float g[8]; unpack8(gw, g);
        f32x4 r0, r1;
#pragma unroll
        for (int i = 0; i < 4; ++i) { r0[i] = a[i] * sigmoidf_(g[i]); r1[i] = b[i] * sigmoidf_(g[4 + i]); }
        *(u32x4*)(proj + (size_t)row * PW + C_MPOOL + col) = pack8(r0, r1);
    }
    __device__ __forceinline__ void apply(const Ld& d, int row, int c0, int, int, int, const f32x4& a0, const f32x4& b0, const f32x4& a1, const f32x4& b1) const { half(d.g0, row, c0, a0, b0); half(d.g1, row, c0 + 128, a1, b1); }
};
struct FMlaUp {
    const bf16_t* proj; bf16_t* merged;
    struct Ld { u32x4 g0, g1, p0, p1; };
    __device__ __forceinline__ void load(Ld& d, int row, int c0, int, int) const {
        d.g0 = *(const u32x4*)(proj + (size_t)row * PW + C_GM + c0); d.g1 = *(const u32x4*)(proj + (size_t)row * PW + C_GM + c0 + 128);
        d.p0 = *(const u32x4*)(proj + (size_t)row * PW + C_MPOOL + c0); d.p1 = *(const u32x4*)(proj + (size_t)row * PW + C_MPOOL + c0 + 128); }
    __device__ __forceinline__ void half(const u32x4& gw, const u32x4& pw, int row, int col, const f32x4& a, const f32x4& b) const {
        float g[8]; unpack8(gw, g); float p[8]; unpack8(pw, p);
        f32x4 r0, r1;
#pragma unroll
        for (int i = 0; i < 4; ++i) { r0[i] = a[i] * sigmoidf_(g[i]) + p[i]; r1[i] = b[i] * sigmoidf_(g[4 + i]) + p[4 + i]; }
        *(u32x4*)(merged + (size_t)row * 1024 + col) = pack8(r0, r1);
    }
    __device__ __forceinline__ void apply(const Ld& d, int row, int c0, int, int, int, const f32x4& a0, const f32x4& b0, const f32x4& a1, const f32x4& b1) const { half(d.g0, d.p0, row, c0, a0, b0); half(d.g1, d.p1, row, c0 + 128, a1, b1); }
};
__device__ __forceinline__ float* hres_row(float* out, float* metah, int row) {
    const int b = row / LP, t = row - b * LP - PADF;
    if (t < 0) return nullptr;
    if (t < NMETA) return metah + (size_t)(b * NMETA + t) * DM;
    return out + ((size_t)b * SEQ + (t - NMETA)) * DM;
}
struct FOut {
    float* out; float* metah; bf16_t* hb; float* ssqh; const float* xin; const float* metain;
    struct Ld { f32x4 v[4]; };
    __device__ __forceinline__ void load(Ld& d, int row, int c0, int, int) const {
        const int b = row / LP, t = row - b * LP - PADF;
        const f32x4 z = (f32x4){0.f, 0.f, 0.f, 0.f}; d.v[0] = z; d.v[1] = z; d.v[2] = z; d.v[3] = z;
        if (t >= 0) { const float* sr = xin ? ((t < NMETA) ? metain + (size_t)t * DM : xin + ((size_t)b * SEQ + (t - NMETA)) * DM) : hres_row(out, metah, row);
            d.v[0] = *(const f32x4*)(sr + c0); d.v[1] = *(const f32x4*)(sr + c0 + 4); d.v[2] = *(const f32x4*)(sr + c0 + 128); d.v[3] = *(const f32x4*)(sr + c0 + 132); }
    }
    __device__ __forceinline__ void apply(const Ld& d, int row, int c0, int pn, int wc, int fq, const f32x4& a0, const f32x4& b0, const f32x4& a1, const f32x4& b1) const {
        float* r = hres_row(out, metah, row);
        f32x4 v0 = (f32x4){0.f, 0.f, 0.f, 0.f}, v1 = v0, v2 = v0, v3 = v0;
        if (r) { v0 = d.v[0] + a0; v1 = d.v[1] + b0; v2 = d.v[2] + a1; v3 = d.v[3] + b1;
            *(f32x4*)(r + c0) = v0; *(f32x4*)(r + c0 + 4) = v1; *(f32x4*)(r + c0 + 128) = v2; *(f32x4*)(r + c0 + 132) = v3; }
        if (!hb) return;
        *(u32x4*)(hb + (size_t)row * DM + c0) = pack8(v0, v1); *(u32x4*)(hb + (size_t)row * DM + c0 + 128) = pack8(v2, v3);
        const f32x4 sq = v0 * v0 + v1 * v1 + v2 * v2 + v3 * v3;
        float ss = (sq[0] + sq[1]) + (sq[2] + sq[3]);
        ss += xor16f(ss); ss += xor32f(ss);
        if (fq == 0) ssqh[(size_t)row * 16 + 4 * pn + wc] = ss;
    }
};
enum { K_IN = 0, K_Q = 1, K_KV = 2, K_POOLUP = 3, K_MLAUP = 4, K_OUT = 5, K_VT = 6 };
struct EpiAll {
    int kind; unsigned char* ws; float* out; const float* gk; const float* xin; const float* metain; int last;
    __device__ __forceinline__ void operator()(const f32x4 (&acc)[2][2][4][2], const pg8::Unit& u, int wr, int wc, int fr, int fq) const {
        bf16_t* proj = (bf16_t*)(ws + WS_PROJ);
        switch (kind) {
            case K_IN:     { pg8::Epi<FIn> e{{proj, (bf16_t*)(ws + WS_KROPE), (const float*)(ws + WS_SSQH), (float*)(ws + WS_SSQQ), (float*)(ws + WS_SSQKV)}}; e(acc, u, wr, wc, fr, fq); } break;
            case K_Q:      { pg8::Epi<FQ> e{{(bf16_t*)(ws + WS_QRAW), (const float*)(ws + WS_SSQQ)}}; e(acc, u, wr, wc, fr, fq); } break;
            case K_KV:     { pg8::Epi<FKV> e{{(bf16_t*)(ws + WS_H), (const bf16_t*)(ws + WS_KROPE), (const float*)(ws + WS_ROPE), (const float*)(ws + WS_SSQKV), gk}}; e(acc, u, wr, wc, fr, fq); } break;
            case K_VT: {
                bf16_t* vt = (bf16_t*)(ws + WS_V); const float* ssqkv = (const float*)(ws + WS_SSQKV);
                const int c0 = u.pn * pg8::BM + wc * 32 + 8 * fq; float sc[2][8];
#pragma unroll
                for (int hf = 0; hf < 2; ++hf)
#pragma unroll
                    for (int i = 0; i < 8; ++i) { const f32x4 pp = *(const f32x4*)(ssqkv + (size_t)(c0 + 128 * hf + i) * 4); sc[hf][i] = __builtin_amdgcn_rsqf(((pp[0] + pp[1]) + (pp[2] + pp[3])) * (1.f / 256.f) + EPS); }
#pragma unroll
                for (int ai = 0; ai < 2; ++ai)
#pragma unroll
                    for (int m = 0; m < 4; ++m) { bf16_t* d = vt + (size_t)(u.pm * pg8::BM + ai * pg8::HALF + wr * 64 + m * 16 + fr) * MP + c0;
#pragma unroll
                        for (int hf = 0; hf < 2; ++hf) { f32x4 x = acc[ai][hf][m][0], y = acc[ai][hf][m][1];
#pragma unroll
                            for (int i = 0; i < 4; ++i) { x[i] *= sc[hf][i]; y[i] *= sc[hf][4 + i]; }
                            *(u32x4*)(d + 128 * hf) = pack8(x, y); }
                        asm volatile("" ::: "memory"); }
            } break;
            case K_POOLUP: { pg8::Epi<FPoolUp> e{{proj}}; e(acc, u, wr, wc, fr, fq); } break;
            case K_MLAUP:  { pg8::Epi<FMlaUp> e{{proj, (bf16_t*)(ws + WS_QRAW)}}; e(acc, u, wr, wc, fr, fq); } break;
            default:       { pg8::Epi<FOut> e{{out, (float*)(ws + WS_METAH), last ? nullptr : (bf16_t*)(ws + WS_H), (float*)(ws + WS_SSQH), xin, metain}}; e(acc, u, wr, wc, fr, fq); } break;
        }
    }
};

__device__ __forceinline__ void tr_item(const float* W, int ldw, int k0, int n0, bf16_t* WT, int ldt, int drow0, int dk0, LAS float* scr, int lane, const float* kgain = nullptr) {
#pragma unroll 8
    for (int i = 0; i < 32; ++i) { const int kk = 2 * i + (lane >> 5); float w = W[(size_t)(k0 + kk) * ldw + n0 + (lane & 31)]; if (kgain) w *= kgain[k0 + kk]; scr[kk * 33 + (lane & 31)] = w; }
    LDS_WAIT(); asm volatile("" ::: "memory");
    const int c = lane & 7;
#pragma unroll
    for (int j = 0; j < 4; ++j) { const int n = (lane >> 3) + 8 * j; const LAS float* s = scr + (8 * c) * 33 + n;
        u32x4 o; o.x = cvt_pk_bf16(s[0 * 33], s[1 * 33]); o.y = cvt_pk_bf16(s[2 * 33], s[3 * 33]); o.z = cvt_pk_bf16(s[4 * 33], s[5 * 33]); o.w = cvt_pk_bf16(s[6 * 33], s[7 * 33]);
        *(u32x4*)(WT + (size_t)(drow0 + n) * ldt + dk0 + 8 * c) = o; }
    LDS_WAIT(); asm volatile("" ::: "memory");
}
__device__ __forceinline__ void wcomb_item(const float* w_in, const float* wg, const float* ngain, bf16_t* WinT, int item, int lane) {
    const int g = item >> 8, kb = (item >> 2) & 63, db = item & 3, kk = lane >> 2, dq = lane & 3, k = kb * 16 + kk, d0 = db * 32 + 8 * dq;
    const float* ap = w_in + (size_t)k * DIN + 128 * g; const float* bp = wg + (size_t)g * 128 * 128 + d0;
    f32x4 c0 = (f32x4){0.f, 0.f, 0.f, 0.f}, c1 = c0;
#pragma unroll 4
    for (int cin = 0; cin < 128; ++cin) { const float av = ap[cin]; const f32x4 b0 = *(const f32x4*)(bp + (size_t)cin * 128), b1 = *(const f32x4*)(bp + (size_t)cin * 128 + 4); c0 += b0 * av; c1 += b1 * av; }
    const float gn = ngain[k];
    bf16_t* o = WinT + (size_t)(128 * g + d0) * 1024 + k;
#pragma unroll
    for (int i = 0; i < 4; ++i) { o[(size_t)i * 1024] = (bf16_t)(cvt_pk_bf16(c0[i] * gn, 0.f) & 0xffffu); o[(size_t)(4 + i) * 1024] = (bf16_t)(cvt_pk_bf16(c1[i] * gn, 0.f) & 0xffffu); }
}
constexpr int CW_I_C = 1024, CW_I_IN = 16 * 129, CW_I_Z = 28, CW_FIRST = CW_I_C + CW_I_IN + CW_I_Z;
__device__ __forceinline__ void convert_weights(const Args& a, int l, LAS unsigned char* lds, unsigned* ctr, int wave, int lane, int lo, int hi) {
    LAS float* scr = (LAS float*)(lds + wave * 16384);
    unsigned char* wb = a.ws + WS_W;
    bf16_t* WinT = (bf16_t*)(wb + W_IN); bf16_t* WqT = (bf16_t*)(wb + W_Q); bf16_t* WkvT = (bf16_t*)(wb + W_KV);
    bf16_t* WpuT = (bf16_t*)(wb + W_PU); bf16_t* WmuT = (bf16_t*)(wb + W_MU); bf16_t* WoT = (bf16_t*)(wb + W_O + (size_t)(l & 1) * 1024 * 1024 * 2);
    const float* w_in = a.w_in + (size_t)l * 1024 * DIN; const float* w_g = a.pool_wg + (size_t)l * 4 * 128 * 128; const float* w_pu = a.pool_wu + (size_t)l * 512 * 1024;
    const float* w_qb = a.w_qb + (size_t)l * 768 * 768; const float* w_kvb = a.w_kvb + (size_t)l * 256 * 1024; const float* w_mu = a.mla_wu + (size_t)l * 512 * 1024; const float* w_o = a.w_out + (size_t)l * 1024 * 1024;
    const float* ngain = a.norm_gain + (size_t)l * DM;
    constexpr int I_C = 1024, I_IN = 16 * 129, I_Q = 12 * 24, I_KV = 4 * 32, I_PU = 8 * 32, I_MU = 8 * 32, I_O = 16 * 32;
    constexpr int I_Z = 28; static_assert(I_C == CW_I_C && I_IN == CW_I_IN && I_Z == CW_I_Z, "item map");
    for (;;) {
        int it = 0; if (lane == 0) it = (int)__hip_atomic_fetch_add(ctr, 1u, __ATOMIC_RELAXED, __HIP_MEMORY_SCOPE_AGENT);
        it = __builtin_amdgcn_readfirstlane(it) + lo;
        if (it >= hi) break;
        int r = it;
        if (r < I_C) { wcomb_item(w_in, w_g, ngain, WinT, r, lane); continue; } r -= I_C;
        if (r < I_IN) { const int kb = r / 129, nb = r % 129 + 16, n0 = nb * 32; const int d = (n0 < 2048) ? n0 : (n0 < 2080 ? 4608 : n0 - 32);
            tr_item(w_in, DIN, kb * 64, n0, WinT, 1024, d, kb * 64, scr, lane, ngain); continue; } r -= I_IN;
        if (r < I_Z) { u32x4* z = (u32x4*)(WinT + (size_t)4640 * 1024) + (size_t)r * 1024 + lane; const u32x4 zz = zero4();
#pragma unroll
            for (int i = 0; i < 16; ++i) z[64 * i] = zz;
            continue; } r -= I_Z;
        if (r < I_Q) { const int kb = r / 24, nb = r % 24; tr_item(w_qb, 768, kb * 64, nb * 32, WqT, 768, nb * 32, kb * 64, scr, lane, a.qa_gain + (size_t)l * 768); continue; } r -= I_Q;
        if (r < I_KV) { const int kb = r / 32, nb = r % 32, h = nb >> 2, q = nb & 3;
            const int d = (q < 2) ? 256 * (h >> 2) + 128 * q + 32 * (h & 3) : 512 + h * 64 + 32 * (q - 2);
            tr_item(w_kvb, 1024, kb * 64, nb * 32, WkvT, 256, d, kb * 64, scr, lane, a.kva_gain + (size_t)l * 256); continue; } r -= I_KV;
        if (r < I_PU) { const int kb = r / 32, nb = r % 32; tr_item(w_pu, 1024, kb * 64, nb * 32, WpuT, 512, nb * 32, kb * 64, scr, lane); continue; } r -= I_PU;
        if (r < I_MU) { const int kb = r / 32, nb = r % 32; tr_item(w_mu, 1024, kb * 64, nb * 32, WmuT, 512, nb * 32, kb * 64, scr, lane); continue; } r -= I_MU;
        { const int kb = r / 32, nb = r % 32; tr_item(w_o, 1024, kb * 64, nb * 32, WoT, 1024, nb * 32, kb * 64, scr, lane); }
    }
}

constexpr int CW_NITEMS = CW_FIRST + 12 * 24 + 4 * 32 + 8 * 32 + 8 * 32 + 16 * 32;
__device__ __forceinline__ void row_to_hb(const float* src, bf16_t* dst, float* ssq16, int lane) {
    unsigned long long* o8 = (unsigned long long*)dst + lane;
    float s = 0.f;
    if (!src) {
#pragma unroll
        for (int j = 0; j < 4; ++j) o8[64 * j] = 0ull;
    } else {
        const f32x4* xr = (const f32x4*)src + lane;
#pragma unroll
        for (int j = 0; j < 4; ++j) { const f32x4 v = xr[64 * j]; s += (v.x * v.x + v.y * v.y) + (v.z * v.z + v.w * v.w);
            o8[64 * j] = (unsigned long long)cvt_pk_bf16(v.x, v.y) | ((unsigned long long)cvt_pk_bf16(v.z, v.w) << 32); }
        s = wave_sum(s);
    }
    if (lane < 16) ssq16[lane] = (lane == 0) ? s : 0.f;
}

__constant__ double c_inv_freq[16] = {1.0, 0.5623413251903491, 0.31622776601683794, 0.1778279410038923, 0.1, 0.05623413251903491, 0.03162277660168379, 0.01778279410038923,
                                       0.01, 0.005623413251903491, 0.0031622776601683794, 0.0017782794100389228, 0.001, 0.0005623413251903491, 0.00031622776601683794, 0.00017782794100389227};
__device__ __forceinline__ void sincos_d(double ang, float& c, float& s) {
    const double k = rint(ang * 0.6366197723675814); const double y = fma(-k, 6.123233995736766e-17, fma(-k, 1.5707963267948966, ang));
    const double y2 = y * y;
    const double sn = y * (1.0 - y2 / 6.0 * (1.0 - y2 / 20.0 * (1.0 - y2 / 42.0 * (1.0 - y2 / 72.0 * (1.0 - y2 / 110.0 * (1.0 - y2 / 156.0))))));
    const double cs = 1.0 - y2 / 2.0 * (1.0 - y2 / 12.0 * (1.0 - y2 / 30.0 * (1.0 - y2 / 56.0 * (1.0 - y2 / 90.0 * (1.0 - y2 / 132.0 * (1.0 - y2 / 182.0))))));
    const int q = ((int)(long long)k) & 3;
    const double cc = (q == 0) ? cs : (q == 1) ? -sn : (q == 2) ? -cs : sn;
    const double ss = (q == 0) ? sn : (q == 1) ? cs : (q == 2) ? -sn : -cs;
    c = (float)cc; s = (float)ss;
}

__device__ __forceinline__ void phase_init(const Args& a, LAS unsigned char* lds, int vcu, int NGW, int wv) {
    const int tid = opaque_tid(wv), lane = tid & 63, wave = __builtin_amdgcn_readfirstlane(tid >> 6), gw = vcu * 8 + wave;
    bf16_t* H = (bf16_t*)(a.ws + WS_H); float* metah = (float*)(a.ws + WS_METAH); float* rope = (float*)(a.ws + WS_ROPE);
    for (int m0 = gw; m0 < MP; m0 += 2 * NGW) {
        f32x4 v[2][4]; const float* srcs[2];
#pragma unroll
        for (int k = 0; k < 2; ++k) { const int m = m0 + k * NGW; srcs[k] = nullptr;
            if (m < MP) { const int b = m / LP, t = m - b * LP - PADF;
                srcs[k] = (t < 0) ? nullptr : (t < NMETA ? a.meta + (size_t)t * DM : a.x + ((size_t)b * SEQ + (t - NMETA)) * DM); }
            if (srcs[k]) {
#pragma unroll
                for (int j = 0; j < 4; ++j) v[k][j] = ((const f32x4*)srcs[k] + lane)[64 * j]; }
            else {
#pragma unroll
                for (int j = 0; j < 4; ++j) v[k][j] = (f32x4){0.f, 0.f, 0.f, 0.f}; } }
#pragma unroll
        for (int k = 0; k < 2; ++k) { const int m = m0 + k * NGW; if (m >= MP) break;
            const int b = m / LP, t = m - b * LP - PADF;
            unsigned long long* o8 = (unsigned long long*)(H + (size_t)m * DM) + lane; float ssum = 0.f;
#pragma unroll
            for (int j = 0; j < 4; ++j) { const f32x4 x = v[k][j]; ssum += (x.x * x.x + x.y * x.y) + (x.z * x.z + x.w * x.w);
                o8[64 * j] = (unsigned long long)cvt_pk_bf16(x.x, x.y) | ((unsigned long long)cvt_pk_bf16(x.z, x.w) << 32); }
            ssum = wave_sum(ssum);
            if (lane < 16) ((float*)(a.ws + WS_SSQH) + (size_t)m * 16)[lane] = (lane == 0) ? ssum : 0.f;
            if (lane < 16) {
                float c = 1.f, sn = 0.f;
                if (t >= 0) { const int p = (t < NMETA) ? t : a.pos[b * SEQ + (t - NMETA)] + NMETA; sincos_d((double)p * c_inv_freq[lane], c, sn); }
                rope[(size_t)m * 32 + lane] = c; rope[(size_t)m * 32 + 16 + lane] = sn;
            }
        }
    }
    convert_weights(a, 0, lds, (unsigned*)(a.ws + WS_CTL) + 8192, wave, lane, 0, CW_FIRST);
}

__device__ __forceinline__ void phase_pool(const Args& a, int l, int vcu, int NGW, int wv) {
    const int tid = opaque_tid(wv), lane = tid & 63, wave = __builtin_amdgcn_readfirstlane(tid >> 6), gw = vcu * 8 + wave;
    bf16_t* proj = (bf16_t*)(a.ws + WS_PROJ);
    const float* sc = a.pool_scale + (size_t)l * 512 + 8 * lane;
    const f32x4 sc0 = *(const f32x4*)sc, sc1 = *(const f32x4*)(sc + 4);
    const int g = lane >> 4, w = 2 << g;
    constexpr int CR = 17, CPB = (LP + CR - 1) / CR;
    for (int ch = gw; ch < BATCH * CPB; ch += NGW) {
        const int bb = ch / CPB, p0 = (ch - bb * CPB) * CR, r0 = bb * LP + p0, nrows = (LP - p0 < CR) ? LP - p0 : CR;
        if (p0 + CR <= PADF) {
            const u32x4 zz = zero4();
            for (int i = 0; i < nrows; ++i) *(u32x4*)(proj + (size_t)(r0 + i) * PW + C_P1Y + 8 * lane) = zz;
            continue; }
        float S[8];
#pragma unroll
        for (int i = 0; i < 8; ++i) S[i] = 0.f;
        for (int j = 1; j < w; ++j) { const u32x4 uw = *(const u32x4*)(proj + (size_t)(r0 - j) * PW + C_U + 8 * lane); float u[8]; unpack8(uw, u);
#pragma unroll
            for (int i = 0; i < 8; ++i) S[i] += u[i]; }
#pragma unroll 2
        for (int i = 0; i < nrows; ++i) {
            const int m = r0 + i, t = p0 + i - PADF;
            bf16_t* prow = proj + (size_t)m * PW;
            const u32x4 uw = *(const u32x4*)(prow + C_U + 8 * lane); float u[8]; unpack8(uw, u);
            const u32x4 zw = *(const u32x4*)(prow + C_Z + 8 * lane); float z[8]; unpack8(zw, z);
            const u32x4 ow = *(const u32x4*)(proj + (size_t)(m - (w - 1)) * PW + C_U + 8 * lane); float o[8]; unpack8(ow, o);
#pragma unroll
            for (int k = 0; k < 8; ++k) S[k] += u[k];
            f32x4 r0v = (f32x4){0.f, 0.f, 0.f, 0.f}, r1v = r0v;
            if (t >= 0) { const int cnt = (t + 1 < w) ? (t + 1) : w; const float ic = 1.0f / (float)cnt;
#pragma unroll
                for (int k = 0; k < 4; ++k) { r0v[k] = (S[k] * ic - u[k]) * sc0[k] * siluf_(z[k]); r1v[k] = (S[4 + k] * ic - u[4 + k]) * sc1[k] * siluf_(z[4 + k]); } }
            *(u32x4*)(prow + C_P1Y + 8 * lane) = pack8(r0v, r1v);
#pragma unroll
            for (int k = 0; k < 8; ++k) S[k] -= o[k];
        }
    }
}

constexpr int KPITCH = 208, VPITCH = 144, KBUF = 64 * KPITCH, VBUF = 64 * VPITCH;
constexpr float QSCALE = 0.1472444460259031f;
constexpr float MASKV = -1e30f;
__device__ __forceinline__ int kvmap(int r, int hi) { return 8 * hi + r + ((r >= 8) ? 8 : 0); }

__device__ __forceinline__ void attn_unit(const Args& a, int l, int b, int h, int R0, bool special, LAS unsigned char* lds, float kb, int wv) {
    const int tid = opaque_tid(wv), lane = tid & 63, wave = __builtin_amdgcn_readfirstlane(tid >> 6), r32 = lane & 31, hi = lane >> 5;
    const bf16_t* qraw = (const bf16_t*)(a.ws + WS_QRAW); const bf16_t* Kb = (const bf16_t*)(a.ws + WS_H); const bf16_t* Vb = (const bf16_t*)(a.ws + WS_V);
    const float* rope = (const float*)(a.ws + WS_ROPE); bf16_t* proj = (bf16_t*)(a.ws + WS_PROJ);
    const float* gq = a.qn_gain + (size_t)l * 96;
    const int qp = R0 + 32 * wave + r32;
    const int mq = b * LP + qp;
    const int TL = special ? 1 : (R0 + 255) / 64;
    const int qmin = R0 + 32 * wave;
    const int tw = (qmin + 31) / 64 < TL ? (qmin + 31) / 64 : TL;
    const bf16_t* Kh = Kb + (size_t)(b * NH + h) * LP * 96;
    LAS unsigned char* KB0 = lds; LAS unsigned char* VB0 = lds + 4 * KBUF;
    int kofs[2], vofs[2];
#pragma unroll
    for (int i = 0; i < 2; ++i) { const int ck = (wave + 8 * i) * 64 + lane, rk = ck / 13, qk = ck - rk * 13; kofs[i] = rk * 96 + (qk < 12 ? qk : 11) * 8;
        const int cv = (i == 0 ? wave : 8) * 64 + lane, rv = cv / 9, qv = cv - rv * 9; vofs[i] = rv * MP + (qv < 8 ? qv : 7) * 8; }
    const bf16_t* Vh = Vb + (size_t)(h * 64) * MP + (size_t)b * LP;
    const int nis = 2 + (wave < 5 ? 1 : 0) + (wave == 0 ? 1 : 0);
#define ATT_DMAK(t) do { const bf16_t* kt = Kh + (size_t)(t) * 64 * 96; LAS unsigned char* kb = KB0 + ((t) & 3) * KBUF; \
        __builtin_amdgcn_global_load_lds((const unsigned*)(kt + kofs[0]), (LAS unsigned*)(kb + wave * 1024), 16, 0, 0); \
        if (wave < 5) __builtin_amdgcn_global_load_lds((const unsigned*)(kt + kofs[1]), (LAS unsigned*)(kb + (wave + 8) * 1024), 16, 0, 0); } while (0)
#define ATT_DMAV(t) do { const bf16_t* vt = Vh + (t) * 64; LAS unsigned char* vb = VB0 + ((t) % 3) * VBUF; \
        __builtin_amdgcn_global_load_lds((const unsigned*)(vt + vofs[0]), (LAS unsigned*)(vb + wave * 1024), 16, 0, 0); \
        if (wave == 0) __builtin_amdgcn_global_load_lds((const unsigned*)(vt + vofs[1]), (LAS unsigned*)(vb + 8 * 1024), 16, 0, 0); } while (0)
    LAS unsigned char* QST = lds + 81920 + wave * 6144;
    LAS unsigned char* RST = (wave < 3) ? lds + wave * 4096 : (wave < 6) ? lds + 3 * KBUF + (wave - 3) * 4096 : lds + 4 * KBUF + (wave - 6) * 4096;
    { const int mq0 = b * LP + R0 + 32 * wave;
#pragma unroll
      for (int j = 0; j < 6; ++j) { const int c = j * 64 + lane, row = c / 12, piece = c - row * 12;
          __builtin_amdgcn_global_load_lds((const unsigned*)(qraw + (size_t)(mq0 + row) * 768 + h * 96 + piece * 8), (LAS unsigned*)(QST + j * 1024), 16, 0, 0); }
#pragma unroll
      for (int j = 0; j < 4; ++j)
          __builtin_amdgcn_global_load_lds((const unsigned*)(rope + (size_t)mq0 * 32 + (j * 64 + lane) * 4), (LAS unsigned*)(RST + j * 1024), 16, 0, 0); }
    ATT_DMAK(1); ATT_DMAV(1); ATT_DMAK(2);
    if (wave == 0) asm volatile("s_waitcnt vmcnt(6)" ::: "memory"); else if (wave < 5) asm volatile("s_waitcnt vmcnt(5)" ::: "memory"); else asm volatile("s_waitcnt vmcnt(3)" ::: "memory");
    bf16x8 qr[6]; float qnorm = 0.f;
    {
        float qf[6][8]; float ss = 0.f;
        const LAS unsigned char* qs = QST + r32 * 192 + hi * 16;
#pragma unroll
        for (int d0 = 0; d0 < 6; ++d0) { const u32x4 w = *(const LAS u32x4*)(qs + 32 * d0); unpack8(w, qf[d0]);
#pragma unroll
            for (int i = 0; i < 8; ++i) ss += qf[d0][i] * qf[d0][i]; }
        ss += xor32f(ss);
        const float inv = __builtin_amdgcn_rsqf(ss * (1.f / 96.f) + EPS);
#pragma unroll
        for (int d0 = 0; d0 < 6; ++d0) { const f32x4 g0 = *(const f32x4*)(gq + 16 * d0 + 8 * hi), g1 = *(const f32x4*)(gq + 16 * d0 + 8 * hi + 4);
#pragma unroll
            for (int i = 0; i < 4; ++i) { qf[d0][i] *= inv * g0[i]; qf[d0][4 + i] *= inv * g1[i]; } }
        const LAS unsigned char* cs = RST + r32 * 128 + hi * 32;
        const f32x4 c0 = *(const LAS f32x4*)(cs), c1 = *(const LAS f32x4*)(cs + 16), s0 = *(const LAS f32x4*)(cs + 64), s1 = *(const LAS f32x4*)(cs + 80);
#pragma unroll
        for (int i = 0; i < 8; ++i) { const float c = (i < 4) ? c0[i & 3] : c1[i & 3], s = (i < 4) ? s0[i & 3] : s1[i & 3]; const float x1 = qf[4][i], x2 = qf[5][i];
            qf[4][i] = x1 * c - x2 * s; qf[5][i] = x2 * c + x1 * s; }
        { float q2 = 0.f;
#pragma unroll
          for (int d0 = 0; d0 < 6; ++d0)
#pragma unroll
              for (int i = 0; i < 8; ++i) q2 += qf[d0][i] * qf[d0][i];
          q2 += xor32f(q2); qnorm = __builtin_amdgcn_sqrtf(q2) * QSCALE; }
#pragma unroll
        for (int d0 = 0; d0 < 6; ++d0) { u32x4 w; w.x = cvt_pk_bf16(qf[d0][0] * QSCALE, qf[d0][1] * QSCALE); w.y = cvt_pk_bf16(qf[d0][2] * QSCALE, qf[d0][3] * QSCALE);
            w.z = cvt_pk_bf16(qf[d0][4] * QSCALE, qf[d0][5] * QSCALE); w.w = cvt_pk_bf16(qf[d0][6] * QSCALE, qf[d0][7] * QSCALE); qr[d0] = __builtin_bit_cast(bf16x8, w); }
    }
    asm volatile("s_waitcnt vmcnt(0) lgkmcnt(0)" ::: "memory"); __builtin_amdgcn_s_barrier(); asm volatile("" ::: "memory");
    ATT_DMAK(3); ATT_DMAV(2);
    const int krow = kvmap((r32 & 3) + 4 * (r32 >> 3), (r32 >> 2) & 1);
    const int koff = krow * KPITCH + 16 * hi, voff = r32 * VPITCH + 16 * hi;
#define ATT_QK(P0, P1, t, C) do { const LAS unsigned char* kb = KB0 + ((t) & 3) * KBUF + koff; P0 = C; P1 = C; \
        _Pragma("unroll") for (int d0 = 0; d0 < 6; ++d0) { const bf16x8 ka = *(const LAS bf16x8*)(kb + 32 * d0), kc = *(const LAS bf16x8*)(kb + 32 * KPITCH + 32 * d0); \
            P0 = __builtin_amdgcn_mfma_f32_32x32x16_bf16(ka, qr[d0], P0, 0, 0, 0); P1 = __builtin_amdgcn_mfma_f32_32x32x16_bf16(kc, qr[d0], P1, 0, 0, 0); } } while (0)
#define ATT_MASK(P0, P1, t, PADCHK) do { _Pragma("unroll") for (int r = 0; r < 16; ++r) { const int kv = 64 * (t) + kvmap(r, hi); \
        if (!(kv <= qp && (!(PADCHK) || kv >= PADF))) P0[r] = MASKV; if (!(kv + 32 <= qp && (!(PADCHK) || kv + 32 >= PADF))) P1[r] = MASKV; } } while (0)
#define ATT_ROWMAX(P0, P1, RM) do { float a_ = fmaxf(fmaxf(P0[0], P0[1]), P1[0]), b_ = fmaxf(fmaxf(P0[2], P0[3]), P1[1]); a_ = fmaxf(fmaxf(a_, P1[2]), P1[3]); \
        _Pragma("unroll") for (int r = 4; r < 16; r += 4) { a_ = fmaxf(fmaxf(a_, P0[r]), P0[r + 1]); b_ = fmaxf(fmaxf(b_, P0[r + 2]), P0[r + 3]); a_ = fmaxf(fmaxf(a_, P1[r]), P1[r + 1]); b_ = fmaxf(fmaxf(b_, P1[r + 2]), P1[r + 3]); } \
        RM = fmaxf(a_, b_); RM = fmaxf(RM, xor32f(RM)); } while (0)
    const bool fixed = kb > 0.f;
    float mref = fixed ? kb * qnorm : 0.f, lsum = 0.f; f32x16 o0 = {}, o1 = {}, pc0 = {}, pc1 = {}, negm;
#pragma unroll
    for (int r = 0; r < 16; ++r) negm[r] = -mref;
    if (tw >= 1) {
        ATT_QK(pc0, pc1, 1, negm);
        ATT_MASK(pc0, pc1, 1, true);
        if (!fixed) {
            float rm; ATT_ROWMAX(pc0, pc1, rm);
            mref = (rm < -1e29f) ? 0.f : rm;
#pragma unroll
            for (int r = 0; r < 16; ++r) { pc0[r] -= mref; pc1[r] -= mref; negm[r] = -mref; }
        }
    }
#define ATT_EXPP(pc0, pc1) do { float ps = 0.f; \
        _Pragma("unroll") for (int r = 0; r < 16; ++r) { pc0[r] = __builtin_amdgcn_exp2f(pc0[r]); pc1[r] = __builtin_amdgcn_exp2f(pc1[r]); ps += pc0[r] + pc1[r]; } \
        lsum += ps; \
        { u32x4 w; w.x = cvtpk_s(pc0[0], pc0[1]); w.y = cvtpk_s(pc0[2], pc0[3]); w.z = cvtpk_s(pc0[4], pc0[5]); w.w = cvtpk_s(pc0[6], pc0[7]); pa[0] = __builtin_bit_cast(bf16x8, w); \
          w.x = cvtpk_s(pc0[8], pc0[9]); w.y = cvtpk_s(pc0[10], pc0[11]); w.z = cvtpk_s(pc0[12], pc0[13]); w.w = cvtpk_s(pc0[14], pc0[15]); pa[1] = __builtin_bit_cast(bf16x8, w); \
          w.x = cvtpk_s(pc1[0], pc1[1]); w.y = cvtpk_s(pc1[2], pc1[3]); w.z = cvtpk_s(pc1[4], pc1[5]); w.w = cvtpk_s(pc1[6], pc1[7]); pa[2] = __builtin_bit_cast(bf16x8, w); \
          w.x = cvtpk_s(pc1[8], pc1[9]); w.y = cvtpk_s(pc1[10], pc1[11]); w.z = cvtpk_s(pc1[12], pc1[13]); w.w = cvtpk_s(pc1[14], pc1[15]); pa[3] = __builtin_bit_cast(bf16x8, w); } } while (0)
#define ATT_EXP() ATT_EXPP(pc0, pc1)
#define ATT_LDV(t) do { const LAS unsigned char* vb = VB0 + ((t) % 3) * VBUF + voff; \
        _Pragma("unroll") for (int k = 0; k < 4; ++k) { vf[2 * k] = *(const LAS bf16x8*)(vb + 32 * k); vf[2 * k + 1] = *(const LAS bf16x8*)(vb + 32 * VPITCH + 32 * k); } } while (0)
#define ATT_PV() do { __builtin_amdgcn_s_setprio(3); _Pragma("unroll") for (int k = 0; k < 4; ++k) { o0 = __builtin_amdgcn_mfma_f32_32x32x16_bf16(vf[2 * k], pa[k], o0, 0, 0, 0); o1 = __builtin_amdgcn_mfma_f32_32x32x16_bf16(vf[2 * k + 1], pa[k], o1, 0, 0, 0); } if (wave >= 4) __builtin_amdgcn_s_setprio(1); else __builtin_amdgcn_s_setprio(0); } while (0)
    if (wave >= 4) __builtin_amdgcn_s_setprio(1);
#define ATT_ISSUE(t) do { if ((t) + 3 <= TL) ATT_DMAK((t) + 3); if ((t) + 2 <= TL) ATT_DMAV((t) + 2); } while (0)
#define ATT_SYNC(t) do { if ((t) + 3 <= TL) { if (nis == 4) asm volatile("s_waitcnt vmcnt(4)" ::: "memory"); else if (nis == 3) asm volatile("s_waitcnt vmcnt(3)" ::: "memory"); else asm volatile("s_waitcnt vmcnt(2)" ::: "memory"); } \
        else asm volatile("s_waitcnt vmcnt(0)" ::: "memory"); \
        LDS_WAIT(); __builtin_amdgcn_s_barrier(); asm volatile("" ::: "memory"); } while (0)
#define ATT_BODY(t, C0, C1, N0, N1) do { ATT_ISSUE(t); \
        bf16x8 vf[8], pa[4]; \
        { const LAS unsigned char* kb_ = KB0 + (((t) + 1) & 3) * KBUF + koff; bf16x8 kf[6]; \
          _Pragma("unroll") for (int d0 = 0; d0 < 3; ++d0) { kf[2 * d0] = *(const LAS bf16x8*)(kb_ + 32 * d0); kf[2 * d0 + 1] = *(const LAS bf16x8*)(kb_ + 32 * KPITCH + 32 * d0); } \
          N0 = __builtin_amdgcn_mfma_f32_32x32x16_bf16(kf[0], qr[0], negm, 0, 0, 0); N1 = __builtin_amdgcn_mfma_f32_32x32x16_bf16(kf[1], qr[0], negm, 0, 0, 0); \
          _Pragma("unroll") for (int d0 = 1; d0 < 3; ++d0) { N0 = __builtin_amdgcn_mfma_f32_32x32x16_bf16(kf[2 * d0], qr[d0], N0, 0, 0, 0); N1 = __builtin_amdgcn_mfma_f32_32x32x16_bf16(kf[2 * d0 + 1], qr[d0], N1, 0, 0, 0); } \
          __builtin_amdgcn_sched_barrier(0); \
          _Pragma("unroll") for (int d0 = 3; d0 < 6; ++d0) { kf[2 * (d0 - 3)] = *(const LAS bf16x8*)(kb_ + 32 * d0); kf[2 * (d0 - 3) + 1] = *(const LAS bf16x8*)(kb_ + 32 * KPITCH + 32 * d0); } \
          _Pragma("unroll") for (int d0 = 3; d0 < 6; ++d0) { N0 = __builtin_amdgcn_mfma_f32_32x32x16_bf16(kf[2 * (d0 - 3)], qr[d0], N0, 0, 0, 0); N1 = __builtin_amdgcn_mfma_f32_32x32x16_bf16(kf[2 * (d0 - 3) + 1], qr[d0], N1, 0, 0, 0); } } \
        ATT_LDV(t); ATT_EXPP(C0, C1); ATT_PV(); \
        if (64 * ((t) + 1) + 63 > qmin) ATT_MASK(N0, N1, (t) + 1, false); \
        if (!fixed) { float rm; ATT_ROWMAX(N0, N1, rm); \
            if (__any(rm > 8.f)) { const float d = (rm > 8.f) ? rm : 0.f; const float f = __builtin_amdgcn_exp2f(-d); mref += d; lsum *= f; \
                _Pragma("unroll") for (int r = 0; r < 16; ++r) { N0[r] -= d; N1[r] -= d; negm[r] -= d; o0[r] *= f; o1[r] *= f; } } } \
        ATT_SYNC(t); } while (0)
#define ATT_TAIL(t, C0, C1) do { ATT_ISSUE(t); bf16x8 vf[8], pa[4]; ATT_LDV(t); ATT_EXPP(C0, C1); ATT_PV(); ATT_SYNC(t); } while (0)
    {
        f32x16 pb0, pb1; int t = 1;
        for (; t + 1 < tw; t += 2) { ATT_BODY(t, pc0, pc1, pb0, pb1); ATT_BODY(t + 1, pb0, pb1, pc0, pc1); }
        if (t < tw) { ATT_BODY(t, pc0, pc1, pb0, pb1); ++t; ATT_TAIL(t, pb0, pb1); ++t; }
        else if (t == tw) { ATT_TAIL(t, pc0, pc1); ++t; }
        for (; t <= TL; ++t) { ATT_ISSUE(t); ATT_SYNC(t); }
    }
    __builtin_amdgcn_s_setprio(0);
#undef ATT_ISSUE
#undef ATT_SYNC
#undef ATT_BODY
#undef ATT_TAIL
#undef ATT_EXPP
#undef ATT_EXP
#undef ATT_LDV
#undef ATT_PV
#undef ATT_DMAK
#undef ATT_DMAV
#undef ATT_QK
#undef ATT_MASK
#undef ATT_ROWMAX
    lsum += xor32f(lsum);
    const float il = (lsum > 0.f) ? 1.0f / lsum : 0.f;
    if (!(special && wave >= 4)) {
        bf16_t* prow = proj + (size_t)mq * PW + h * 64 + (hi ? 8 : 0);
#pragma unroll
        for (int db = 0; db < 2; ++db)
#pragma unroll
            for (int gp = 0; gp < 2; ++gp) {
                const f32x16& o = db ? o1 : o0;
                float v[8];
#pragma unroll
                for (int i = 0; i < 4; ++i) {
                    const auto rr = __builtin_amdgcn_permlane32_swap(__float_as_uint(o[8 * gp + i]), __float_as_uint(o[8 * gp + 4 + i]), false, false);
                    v[i] = __uint_as_float(rr[0]); v[4 + i] = __uint_as_float(rr[1]); }
                const int col = 32 * db + 16 * gp;
                const u32x4 zw = *(const u32x4*)(prow + C_ZM + col); float z[8]; unpack8(zw, z);
                f32x4 r0, r1;
#pragma unroll
                for (int i = 0; i < 4; ++i) { r0[i] = v[i] * il * siluf_(z[i]); r1[i] = v[4 + i] * il * siluf_(z[4 + i]); }
                *(u32x4*)(prow + C_OZ + col) = pack8(r0, r1);
            }
    }
}
__device__ __forceinline__ void phase_attn(const Args& a, int l, LAS unsigned char* lds, int vcu, int G, int wv) {
    float kb;
    { const float* gq = a.qn_gain + (size_t)l * 96; const float* gk = a.kn_gain + (size_t)l * 96;
      float mq = 0.f, mk = 0.f;
      for (int i = 0; i < 96; ++i) { mq = fmaxf(mq, fabsf(gq[i])); mk = fmaxf(mk, fabsf(gk[i])); }
      kb = 1.01f * 9.7979590f * mk;
      const float hi = kb * 9.7979590f * mq * QSCALE;
      if (!(hi < 48.f)) kb = -1.f; }
    const int sp0 = (G == 256) ? ((vcu >= 33 && vcu < 64) ? vcu - 33 : (vcu == 65 ? 31 : -1)) : (vcu < 32 ? vcu : -1);
    const int nmain = (vcu < 512) ? 2 * ((512 - vcu + G - 1) / G) : 0, nspec = (G == 256) ? (sp0 >= 0 ? 1 : 0) : ((vcu < 32) ? (32 - vcu + G - 1) / G : 0);
    for (int j = 0; j < nmain + nspec; ++j) {
        int b, h, R0; bool special;
        if (j < nmain) { const int it = vcu + (j >> 1) * G, bh = it >> 4, s = it & 15; b = bh >> 3; h = bh & 7; R0 = 128 + 256 * ((j & 1) ? s : 31 - s); special = false; }
        else { const int it = (G == 256) ? sp0 : vcu + (j - nmain) * G; b = it >> 3; h = it & 7; R0 = 0; special = true; }
        attn_unit(a, l, b, h, R0, special, lds, kb, wv);
    }
}

constexpr int NPHASE = 1 + 5 * DEPTH;
__global__ void __launch_bounds__(512, 2) trunk_fwd(Args a0) {
    extern __shared__ __attribute__((aligned(16))) unsigned char lds_raw[];
    LAS unsigned char* lds = (LAS unsigned char*)lds_raw;
    const int G = gridDim.x, bx = blockIdx.x;
    const int wv = __builtin_amdgcn_readfirstlane(threadIdx.x >> 6);
    const int vcu = (G % 8 == 0) ? (bx % 8) * (G / 8) + bx / 8 : bx;
    const int NGW = G * 8;
    for (int u = opaque_tid(wv); u < (LDS_BYTES - 131072) / 4; u += 512) ((LAS unsigned*)(lds + 131072))[u] = 0u;
    __syncthreads();
    XcdBarrier bar = xcd_barrier_post((unsigned*)(a0.ws + WS_CTL) + 4096, (volatile LAS unsigned*)(lds + MISC_OFF) + 8, opaque_tid(wv));
    for (int ph = a0.ph_lo; ph < a0.ph_hi; ++ph) {
        Args a = a0; { size_t off = 0; asm volatile("" : "+s"(off)); a.ws = a0.ws + off; }
        unsigned char* ws = a.ws;
        if (ph == 0) phase_init(a, lds, vcu, NGW, wv);
        else {
            const int l = (ph - 1) / 5, sp = (ph - 1) % 5;
            if (sp == 1) phase_pool(a, l, vcu, NGW, wv);
            else if (sp == 2) phase_attn(a, l, lds, vcu, G, wv);
            for (int j = 0; j < 3; ++j) {
                pg8::Gemm g{nullptr, 0, nullptr, 0, MP, 0, 0, 0};
                EpiAll E{K_IN, ws, a.out, a.kn_gain + (size_t)l * 96, (l == 0) ? a.x : nullptr, a.meta, (l == DEPTH - 1) ? 1 : 0};
                const bf16_t* PROJ = (const bf16_t*)(ws + WS_PROJ); const unsigned char* wb = ws + WS_W;
                if (sp == 0 && j == 0)      { g.A = (const bf16_t*)(ws + WS_H); g.lda = 1024; g.Bt = (const bf16_t*)(wb + W_IN); g.ldb = 1024; g.N = NIN_PAD; g.K = 1024; E.kind = K_IN; }
                else if (sp == 1 && j == 0) { g.A = PROJ + C_CQ; g.lda = PW; g.Bt = (const bf16_t*)(wb + W_Q); g.ldb = 768; g.N = 768; g.K = 768; E.kind = K_Q; }
                else if (sp == 1 && j == 1) { g.A = PROJ + C_CKV; g.lda = PW; g.Bt = (const bf16_t*)(wb + W_KV); g.ldb = 256; g.N = 512; g.K = 256; E.kind = K_KV; }
                else if (sp == 1 && j == 2) { g.A = (const bf16_t*)(wb + W_KV) + 512 * 256; g.lda = 256; g.Bt = PROJ + C_CKV; g.ldb = PW; g.M = 512; g.N = MP; g.K = 256; E.kind = K_VT; }
                else if (sp == 2 && j == 0) { g.A = PROJ + C_P1Y; g.lda = PW; g.Bt = (const bf16_t*)(wb + W_PU); g.ldb = 512; g.N = 1024; g.K = 512; E.kind = K_POOLUP; }
                else if (sp == 3 && j == 0) { g.A = PROJ + C_OZ; g.lda = PW; g.Bt = (const bf16_t*)(wb + W_MU); g.ldb = 512; g.N = 1024; g.K = 512; E.kind = K_MLAUP; }
                else if (sp == 4 && j == 0) { g.A = (const bf16_t*)(ws + WS_QRAW)  ; g.lda = 1024; g.Bt = (const bf16_t*)(wb + W_O) + (size_t)(l & 1) * 1024 * 1024; g.ldb = 1024; g.N = 1024; g.K = 1024; E.kind = K_OUT; }
                else break;
                const int rot = (E.kind == K_KV) ? 134 : (E.kind == K_VT) ? 138 : 0;
                pg8::StaticOrder S; S.init(g.M, g.N, G, (bx + G - rot % G) % G); pg8::gemm_phase(lds, g, S, E, wv);
            }
            if ((sp == 4 && l + 1 < DEPTH) || (sp == 0 && l == 0)) {
                const int tid = opaque_tid(wv), lane = tid & 63, wave = __builtin_amdgcn_readfirstlane(tid >> 6);
                const bool nxt = (sp == 4);
                convert_weights(a, nxt ? l + 1 : 0, lds, (unsigned*)(ws + WS_CTL) + 8192 + 64 * (nxt ? l + 1 : 5), wave, lane, nxt ? 0 : CW_FIRST, CW_NITEMS);
            }
        }
        if (ph + 1 < a0.ph_hi) { if (ph == 0) { __syncthreads(); cg::this_grid().sync(); } else xcd_barrier(bar, opaque_tid(wv)); }
    }
}

extern "C" void kernel_launch(void* const* d_in, const int* in_sizes, int n_in, void* d_out, int out_size, void* d_ws, size_t ws_size, hipStream_t stream) {
    static int grid = 0;
    if (grid == 0) {
        if (n_in != 16 || out_size != BATCH * SEQ * DM || ws_size < WS_END) { fprintf(stderr, "kernel_launch: unexpected shapes (n_in %d out %d ws %zu)\n", n_in, out_size, ws_size); grid = -1; return; }
        int dev = 0, cus = 0, per_cu = 0;
        hipGetDevice(&dev); hipDeviceGetAttribute(&cus, hipDeviceAttributeMultiprocessorCount, dev);
        if (hipFuncSetAttribute((const void*)trunk_fwd, hipFuncAttributeMaxDynamicSharedMemorySize, LDS_BYTES) != hipSuccess) { fprintf(stderr, "kernel_launch: hipFuncSetAttribute failed\n"); grid = -1; return; }
        if (hipOccupancyMaxActiveBlocksPerMultiprocessor(&per_cu, (const void*)trunk_fwd, 512, LDS_BYTES) != hipSuccess || per_cu < 1) { fprintf(stderr, "kernel_launch: occupancy query says %d\n", per_cu); per_cu = 1; }
        (void)hipGetLastError();
        grid = cus * 1;
    }
    if (grid < 0) return;
    Args a{};
    a.x = (const float*)d_in[0]; a.pos = (const int*)d_in[1]; a.meta = (const float*)d_in[2]; a.norm_gain = (const float*)d_in[3]; a.w_in = (const float*)d_in[4];
    a.pool_wg = (const float*)d_in[5]; a.pool_scale = (const float*)d_in[6]; a.pool_wu = (const float*)d_in[7]; a.qa_gain = (const float*)d_in[8]; a.kva_gain = (const float*)d_in[9];
    a.w_qb = (const float*)d_in[10]; a.w_kvb = (const float*)d_in[11]; a.qn_gain = (const float*)d_in[12]; a.kn_gain = (const float*)d_in[13]; a.mla_wu = (const float*)d_in[14]; a.w_out = (const float*)d_in[15];
    a.out = (float*)d_out; a.ws = (unsigned char*)d_ws;
    if (hipMemsetAsync((char*)d_ws + WS_CTL, 0, CTL_ZERO_BYTES, stream) != hipSuccess) { fprintf(stderr, "kernel_launch: memset failed\n"); return; }
#if MK_COOP
    a.ph_lo = 0; a.ph_hi = NPHASE;
    void* args[] = {&a};
    hipError_t e = hipLaunchCooperativeKernel((const void*)trunk_fwd, dim3(grid), dim3(512), args, LDS_BYTES, stream);
    if (e != hipSuccess) fprintf(stderr, "cooperative launch failed: %s (grid %d)\n", hipGetErrorString(e), grid);
#else
    for (int ph = 0; ph < NPHASE; ++ph) { a.ph_lo = ph; a.ph_hi = ph + 1; hipLaunchKernelGGL(trunk_fwd, dim3(grid), dim3(512), LDS_BYTES, stream, a); }
#endif
}
```

```cpp
#include <hip/hip_runtime.h>
#include <hip/hip_cooperative_groups.h>
#include <cstdio>
#include <cstdint>
namespace cg = cooperative_groups;

#ifndef MK_COOP
#define MK_COOP 1
#endif

#define LAS __attribute__((address_space(3)))
typedef unsigned short bf16_t;
typedef short bf16x8 __attribute__((ext_vector_type(8)));
typedef float f32x4 __attribute__((ext_vector_type(4)));
typedef float f32x16 __attribute__((ext_vector_type(16)));
typedef unsigned u32x4 __attribute__((ext_vector_type(4)));
typedef unsigned u32x2 __attribute__((ext_vector_type(2)));

constexpr int BATCH = 4, SEQ = 8192, DM = 1024, DEPTH = 4, NMETA = 16;
constexpr int PADF = 112, LP = 8320, MP = BATCH * LP;
constexpr int NH = 8;
constexpr int DIN = 4640;
constexpr float EPS = 1e-6f;
constexpr int PW = 4608;
constexpr int C_U = 0  , C_Z = 512, C_CQ = 1024, C_CKV = 1792, C_ZM = 2048, C_GP = 2560, C_GM = 3584;
constexpr int C_P1Y = 512  , C_MPOOL = 1024  , C_OZ = 0  ;
constexpr int NIN_PAD = 4864;

constexpr size_t MiB = 1u << 20;
constexpr size_t WS_CTL = 0, CTL_ZERO_BYTES = 65536;
constexpr size_t WS_W = 1 * MiB;
constexpr size_t W_IN = 0, W_Q = W_IN + (size_t)NIN_PAD * 1024 * 2, W_KV = W_Q + 768 * 768 * 2, W_G = W_KV + 1024 * 256 * 2,
                 W_PU = W_G + 512 * 256 * 2, W_MU = W_PU + 1024 * 512 * 2, W_O = W_MU + 1024 * 512 * 2  , W_END = W_O + 2 * 1024 * 1024 * 2;
static_assert(W_END <= 18 * MiB, "weights");
constexpr size_t WS_ROPE = 19 * MiB, WS_SSQH = 24 * MiB  , WS_SSQQ = 27 * MiB  , WS_SSQKV = 29 * MiB  ,
                 WS_METAH = 30 * MiB, WS_KROPE = 31 * MiB, WS_H = 34 * MiB  , WS_PROJ = 99 * MiB, WS_QRAW = 392 * MiB  , WS_V = 441 * MiB, WS_END = 474 * MiB;
static_assert(WS_H + (size_t)MP * 1024 * 2 <= WS_PROJ && WS_PROJ + (size_t)MP * PW * 2 <= WS_QRAW && WS_QRAW + (size_t)MP * 768 * 2 <= WS_V && WS_V + (size_t)MP * 512 * 2 <= WS_END && WS_QRAW + (size_t)MP * 1024 * 2 <= WS_END, "ws map");

constexpr int LDS_BYTES = 147456, MISC_OFF = 131072 + 320;

struct Args {
    const float* x; const int* pos; const float* meta; const float* norm_gain; const float* w_in; const float* pool_wg; const float* pool_scale; const float* pool_wu;
    const float* qa_gain; const float* kva_gain; const float* w_qb; const float* w_kvb; const float* qn_gain; const float* kn_gain; const float* mla_wu; const float* w_out;
    float* out; unsigned char* ws; int ph_lo, ph_hi;
};

__device__ __forceinline__ unsigned cvt_pk_bf16(float lo, float hi) { unsigned r; asm volatile("v_cvt_pk_bf16_f32 %0, %1, %2" : "=v"(r) : "v"(lo), "v"(hi)); return r; }
typedef float f32x2_t __attribute__((ext_vector_type(2))); typedef __bf16 bf16x2_t __attribute__((ext_vector_type(2)));
__device__ __forceinline__ unsigned cvtpk_s(float lo, float hi) { f32x2_t v = {lo, hi}; bf16x2_t b = __builtin_convertvector(v, bf16x2_t); return __builtin_bit_cast(unsigned, b); }
__device__ __forceinline__ float bf_lo(unsigned u) { return __uint_as_float(u << 16); }
__device__ __forceinline__ float bf_hi(unsigned u) { return __uint_as_float(u & 0xffff0000u); }
__device__ __forceinline__ float xor32f(float v) { const auto rr = __builtin_amdgcn_permlane32_swap(__float_as_uint(v), __float_as_uint(v), false, false); const unsigned me = __float_as_uint(v); return __uint_as_float(rr[0] == me ? rr[1] : rr[0]); }
__device__ __forceinline__ float xor16f(float v) { return __uint_as_float((unsigned)__builtin_amdgcn_ds_swizzle((int)__float_as_uint(v), 0x401F)); }
template <int M> __device__ __forceinline__ float xorswz(float v) { return __uint_as_float((unsigned)__builtin_amdgcn_ds_swizzle((int)__float_as_uint(v), (M << 10) | 0x1F)); }
__device__ __forceinline__ float wave_sum(float v) {
    v += xorswz<1>(v); v += xorswz<2>(v); v += xorswz<4>(v); v += xorswz<8>(v); v += xorswz<16>(v); v += xor32f(v);
    return v;
}
__device__ __forceinline__ float sigmoidf_(float g) { return __builtin_amdgcn_rcpf(1.f + __expf(-g)); }
__device__ __forceinline__ float siluf_(float z) { return z * sigmoidf_(z); }
#define LDS_WAIT() asm volatile("s_waitcnt lgkmcnt(0)" ::: "memory")
__device__ __forceinline__ u32x4 zero4() { unsigned z = 0u; asm volatile("" : "+v"(z)); return (u32x4){z, z, z, z}; }
__device__ __forceinline__ int opaque_tid(int wv) { int t = wv * 64 + (int)__builtin_amdgcn_mbcnt_hi(~0u, __builtin_amdgcn_mbcnt_lo(~0u, 0u)); asm volatile("" : "+v"(t)); return t; }

#define XB_TMO      128
#define XB_XCNT(j)  (256  + 64 * (j))
#define XB_XSUB(j)  (1280 + 64 * (j))
#define XB_XGEN(j)  (2304 + 64 * (j))
#define XB_TOP      3328
#define XB_TOPGEN   3392
#define XCD_BAR_WORDS 3456
#define XB_SPIN_CAP (1u << 18)

__device__ __forceinline__ unsigned xb_ld(unsigned* p)              { return __hip_atomic_load(p, __ATOMIC_RELAXED, __HIP_MEMORY_SCOPE_AGENT); }
__device__ __forceinline__ unsigned xb_add(unsigned* p, unsigned v) { return __hip_atomic_fetch_add(p, v, __ATOMIC_RELAXED, __HIP_MEMORY_SCOPE_AGENT); }
__device__ __forceinline__ unsigned xb_xcc_id() { return (unsigned)__builtin_amdgcn_s_getreg((3 << 11) | 20) & 0xFu; }
#define XB_SPIN(cond, bar) do { unsigned _sp = 0; while (cond) { __builtin_amdgcn_s_sleep(1); \
    if ((++_sp & 255u) == 0u) { if (xb_ld(&(bar)[XB_TMO])) break; if (_sp > XB_SPIN_CAP) { atomicAdd(&(bar)[XB_TMO], 1u); break; } } } } while (0)

struct XcdBarrier {
    unsigned* bar; unsigned x;
    volatile LAS unsigned* st;
};

__device__ __forceinline__ XcdBarrier xcd_barrier_post(unsigned* bar, volatile LAS unsigned* st, int tid) {
    XcdBarrier b; b.bar = bar; b.x = xb_xcc_id(); b.st = st;
    if (tid == 0) (void)xb_add(&bar[XB_XCNT(b.x)], 1u);
    return b;
}
__device__ __forceinline__ void xcd_barrier_complete(unsigned* bar, unsigned x, unsigned& nloc, unsigned& nx) {
    const unsigned G = gridDim.x * gridDim.y * gridDim.z;
    unsigned sum, cnt, mine, sp = 0u;
    for (;;) {
        sum = 0u; cnt = 0u; mine = 0u;
#pragma unroll
        for (unsigned j = 0; j < 16; ++j) { const unsigned c = xb_ld(&bar[XB_XCNT(j)]); sum += c; cnt += (c > 0u) ? 1u : 0u; mine = (j == x) ? c : mine; }
        if (sum == G) break;
        __builtin_amdgcn_s_sleep(1);
        if ((++sp & 255u) == 0u) { if (xb_ld(&bar[XB_TMO])) break; if (sp > XB_SPIN_CAP) { atomicAdd(&bar[XB_TMO], 1u); break; } }
    }
    nloc = mine > 0u ? mine : 1u; nx = cnt > 0u ? cnt : 1u;
}

__device__ __forceinline__ void xcd_barrier(const XcdBarrier& b, int tid) {
    asm volatile("s_waitcnt vmcnt(0)" ::: "memory");
    __syncthreads();
    if (tid == 0) {
        unsigned* bar = b.bar;
        __builtin_amdgcn_s_waitcnt(0);
        unsigned nloc = b.st[0], nx = b.st[1];
        if (nloc == 0u) { xcd_barrier_complete(bar, b.x, nloc, nx); b.st[0] = nloc; b.st[1] = nx; }
        const unsigned old = xb_add(&bar[XB_XSUB(b.x)], 1u);
        const unsigned gen = old / nloc;
        if (old + 1u == (gen + 1u) * nloc) {
            __builtin_amdgcn_fence(__ATOMIC_RELEASE, "agent");
            asm volatile("s_waitcnt vmcnt(0)" ::: "memory");
            const unsigned og = xb_add(&bar[XB_TOP], 1u);
            const unsigned tg = og / nx;
            if (og + 1u == (tg + 1u) * nx) xb_add(&bar[XB_TOPGEN], 1u);
            else XB_SPIN(xb_ld(&bar[XB_TOPGEN]) == tg, bar);
            __builtin_amdgcn_fence(__ATOMIC_ACQUIRE, "agent");
            xb_add(&bar[XB_XGEN(b.x)], 1u);
            asm volatile("s_waitcnt vmcnt(0)" ::: "memory");
        } else {
            XB_SPIN(xb_ld(&bar[XB_XGEN(b.x)]) == gen, bar);
            __builtin_amdgcn_fence(__ATOMIC_ACQUIRE, "agent");
            asm volatile("s_waitcnt vmcnt(0)" ::: "memory");
        }
    }
    __syncthreads();
}

namespace pg8 {
constexpr int BM = 256, BK = 64, HALF = 128, HTB = HALF * BK * 2, STAGE_BYTES = 8 * HTB, NXCD = 8, WGM = 8;
__host__ __device__ __forceinline__ int lds_byte(int r, int c) { const int st = (r >> 4) * 2 + (c >> 5), rr = r & 15, cc = c & 31, ob = rr * 64 + cc * 2; return st * 1024 + (ob ^ (((ob >> 9) & 1) << 5)); }
__host__ __device__ __forceinline__ void stage_rc(int b, int& R, int& C) { const int st = b / 1024, sb = b % 1024, swz = sb ^ (((sb >> 9) & 1) << 5); R = (st >> 1) * 16 + swz / 64; C = (st & 1) * 32 + (swz % 64) / 2; }
__host__ __device__ __forceinline__ int perm32(int rho) { const int n = rho >> 4, i = rho & 15; return 8 * (i >> 2) + 4 * n + (i & 3); }
struct Unit { int pm, pn; };
struct Gemm { const bf16_t* A; int lda; const bf16_t* Bt; int ldb; int M, N, K; int apn; };
struct StaticOrder {
    int nM, nN, nwg, G, c;
    __device__ void init(int M, int N, int G_, int c_) { nM = M / BM; nN = N / BM; nwg = nM * nN; G = G_; c = c_; }
    __device__ bool next(int i, Unit& u) const {
        const long L = (long)i * G + c; if (L >= nwg) return false;
        int wgid = (int)L; { const int q = nwg / NXCD, r = nwg % NXCD, xcd = wgid % NXCD, off = wgid / NXCD; wgid = (xcd < r ? xcd * (q + 1) : r * (q + 1) + (xcd - r) * q) + off; }
        const int nig = WGM * nN, gid = wgid / nig, fm = gid * WGM, gsz = (nM - fm) < WGM ? (nM - fm) : WGM;
        u.pm = fm + ((wgid % nig) % gsz); u.pn = (wgid % nig) / gsz; return true;
    }
};
template <class F> struct Epi {
    F f;
    __device__ __forceinline__ void operator()(const f32x4 (&acc)[2][2][4][2], const Unit& u, int wr, int wc, int fr, int fq) const {
        const int c0 = u.pn * BM + wc * 32 + 8 * fq;
#pragma unroll
        for (int ai = 0; ai < 2; ++ai)
#pragma unroll
            for (int mp = 0; mp < 4; mp += 2) {
                typename F::Ld ld[2];
#pragma unroll
                for (int m = 0; m < 2; ++m) f.load(ld[m], u.pm * BM + ai * HALF + wr * 64 + (mp + m) * 16 + fr, c0, u.pn, fq);
#pragma unroll
                for (int m = 0; m < 2; ++m) f.apply(ld[m], u.pm * BM + ai * HALF + wr * 64 + (mp + m) * 16 + fr, c0, u.pn, wc, fq, acc[ai][0][mp + m][0], acc[ai][0][mp + m][1], acc[ai][1][mp + m][0], acc[ai][1][mp + m][1]);
            }
    }
};

template <class EpiT>
__device__ __forceinline__ void gemm_phase(LAS unsigned char* lds, const Gemm g, const StaticOrder& S, const EpiT& E, int wv) {
    const int tid = opaque_tid(wv), wid = __builtin_amdgcn_readfirstlane(tid >> 6), lane = tid & 63, wr = wid >> 2, wc = wid & 3, fr = lane & 15, fq = lane >> 4;
    int K = g.K; asm volatile("" : "+s"(K)); const int nt = K / BK;
    unsigned voffA[2], voffB[2];
#pragma unroll
    for (int i = 0; i < 2; ++i) { int R, C; stage_rc(tid * 16 + i * 8192, R, C); const int Rb = (R & ~31) + perm32(R & 31);
        voffA[i] = (unsigned)(R * g.lda + C) * 2u; voffB[i] = (unsigned)(Rb * g.ldb + C) * 2u; }
    const size_t kstep = (size_t)(BK * 2);
    const size_t hA = (size_t)HALF * g.lda * 2, hB = (size_t)HALF * g.ldb * 2;
    const size_t tA = 2 * hA, tB = 2 * hB;
    const unsigned ldsw = (unsigned)wid * 1024u;
    const int aoff = lds_byte(wr * 64 + fr, fq * 8), boff = lds_byte(wc * 32 + fr, fq * 8);
#define PG8_SA(b, h) (((b) * 2 + (h)) * HTB)
#define PG8_SB(b, h) ((4 + (b) * 2 + (h)) * HTB)
#define PG8_STAGE(bufoff, gbase, voff) do { _Pragma("unroll") for (int _i = 0; _i < 2; ++_i) \
        __builtin_amdgcn_global_load_lds((const unsigned*)((const char*)(gbase) + (voff)[_i]), (LAS unsigned*)(lds + (bufoff) + ldsw + _i * 8192), 16, 0, 0); } while (0)
#define PG8_LDA(dst, b, h) do { _Pragma("unroll") for (int m = 0; m < 4; ++m) _Pragma("unroll") for (int k = 0; k < 2; ++k) dst[m][k] = *(const LAS bf16x8*)(lds + PG8_SA(b, h) + aoff + m * 2048 + k * 1024); } while (0)
#define PG8_LDB(dst, b, h) do { _Pragma("unroll") for (int n = 0; n < 2; ++n) _Pragma("unroll") for (int k = 0; k < 2; ++k) dst[n][k] = *(const LAS bf16x8*)(lds + PG8_SB(b, h) + boff + n * 2048 + k * 1024); } while (0)
#define PG8_MMA(ai, bj, At, Bt) do { __builtin_amdgcn_s_setprio(1); _Pragma("unroll") for (int m = 0; m < 4; ++m) _Pragma("unroll") for (int n = 0; n < 2; ++n) _Pragma("unroll") for (int k = 0; k < 2; ++k) \
        acc[ai][bj][m][n] = __builtin_amdgcn_mfma_f32_16x16x32_bf16(Bt[n][k], At[m][k], acc[ai][bj][m][n], 0, 0, 0); __builtin_amdgcn_s_setprio(0); } while (0)
#define PG8_WAIT_V(n) asm volatile("s_waitcnt vmcnt(" #n ")" ::: "memory")
#define PG8_WAIT_L(n) asm volatile("s_waitcnt lgkmcnt(" #n ")" ::: "memory")
#define PG8_BAR __builtin_amdgcn_s_barrier()
#define PG8_SCHED __builtin_amdgcn_sched_barrier(0)
    Unit cur, nxt; int ui = 0;
    if (!S.next(0, cur)) return;
    f32x4 acc[2][2][4][2];
    { float z = 0.f; asm volatile("" : "+v"(z));
#pragma unroll
    for (int a = 0; a < 2; ++a)
#pragma unroll
        for (int b = 0; b < 2; ++b)
#pragma unroll
            for (int m = 0; m < 4; ++m)
#pragma unroll
                for (int n = 0; n < 2; ++n) acc[a][b][m][n] = (f32x4){z, z, z, z}; }
    bf16x8 At[4][2], B0[2][2], B1[2][2];
    const char* cA = (const char*)g.A + (size_t)cur.pm * tA + (size_t)cur.pn * g.apn * 2; const char* cB = (const char*)g.Bt + (size_t)cur.pn * tB;
    PG8_STAGE(PG8_SB(0, 0), cB, voffB); PG8_STAGE(PG8_SB(0, 1), cB + hB, voffB); PG8_STAGE(PG8_SA(0, 0), cA, voffA); PG8_STAGE(PG8_SA(0, 1), cA + hA, voffA);
    if (wr == 1) PG8_BAR;
    PG8_WAIT_V(2); PG8_BAR;
    PG8_STAGE(PG8_SB(1, 0), cB + kstep, voffB); PG8_STAGE(PG8_SA(1, 0), cA + kstep, voffA); PG8_STAGE(PG8_SB(1, 1), cB + hB + kstep, voffB);
    PG8_WAIT_V(6); PG8_BAR;
    for (;;) {
        const bool has_next = S.next(ui + 1, nxt);
        const char* nA = has_next ? (const char*)g.A + (size_t)nxt.pm * tA + (size_t)nxt.pn * g.apn * 2 : cA; const char* nB = has_next ? (const char*)g.Bt + (size_t)nxt.pn * tB : cB;
#pragma unroll 1
        for (int t = 0; t < nt; t += 2) {
            const bool last = (t == nt - 2);
            const char* a1 = cA + (size_t)(t + 1) * kstep;
            const char* a2 = last ? nA : cA + (size_t)(t + 2) * kstep; const char* b2 = last ? nB : cB + (size_t)(t + 2) * kstep;
            const char* a3 = a2 + kstep; const char* b3 = b2 + kstep;
            PG8_LDB(B0, 0, 0); PG8_LDB(B1, 0, 1); PG8_SCHED; PG8_LDA(At, 0, 0); PG8_STAGE(PG8_SA(1, 1), a1 + hA, voffA);
            PG8_WAIT_V(8); PG8_WAIT_L(0); PG8_BAR; PG8_MMA(0, 0, At, B0); PG8_MMA(0, 1, At, B1); PG8_BAR; PG8_SCHED;
            PG8_LDA(At, 0, 1); PG8_STAGE(PG8_SB(0, 0), b2, voffB); PG8_STAGE(PG8_SB(0, 1), b2 + hB, voffB); PG8_STAGE(PG8_SA(0, 0), a2, voffA);
            PG8_WAIT_V(8); PG8_WAIT_L(0); PG8_BAR; PG8_MMA(1, 0, At, B0); PG8_MMA(1, 1, At, B1); PG8_BAR; PG8_SCHED;
            PG8_LDB(B0, 1, 0); PG8_LDB(B1, 1, 1); PG8_SCHED; PG8_LDA(At, 1, 0); PG8_STAGE(PG8_SA(0, 1), a2 + hA, voffA);
            PG8_WAIT_V(8); PG8_WAIT_L(0); PG8_BAR; PG8_MMA(0, 0, At, B0); PG8_MMA(0, 1, At, B1); PG8_BAR; PG8_SCHED;
            PG8_LDA(At, 1, 1); PG8_STAGE(PG8_SB(1, 0), b3, voffB); PG8_STAGE(PG8_SB(1, 1), b3 + hB, voffB); PG8_STAGE(PG8_SA(1, 0), a3, voffA);
            PG8_WAIT_V(8); PG8_WAIT_L(0); PG8_BAR; PG8_MMA(1, 0, At, B0); PG8_MMA(1, 1, At, B1); PG8_BAR; PG8_SCHED;
        }
        if (wr == 0) PG8_BAR;
        E(acc, cur, wr, wc, fr, fq);
        if (!has_next) break;
        { float z = 0.f; asm volatile("" : "+v"(z));
#pragma unroll
        for (int a = 0; a < 2; ++a)
#pragma unroll
            for (int b = 0; b < 2; ++b)
#pragma unroll
                for (int m = 0; m < 4; ++m)
#pragma unroll
                    for (int n = 0; n < 2; ++n) acc[a][b][m][n] = (f32x4){z, z, z, z}; }
        cur = nxt; cA = nA; cB = nB; ++ui;
        if (wr == 1) PG8_BAR;
    }
    PG8_WAIT_V(0);
    PG8_BAR;
#undef PG8_SA
#undef PG8_SB
#undef PG8_STAGE
#undef PG8_LDA
#undef PG8_LDB
#undef PG8_MMA
#undef PG8_WAIT_V
#undef PG8_WAIT_L
#undef PG8_BAR
#undef PG8_SCHED
}
}

__device__ __forceinline__ u32x4 pack8(const f32x4& a, const f32x4& b) { u32x4 w; w.x = cvt_pk_bf16(a[0], a[1]); w.y = cvt_pk_bf16(a[2], a[3]); w.z = cvt_pk_bf16(b[0], b[1]); w.w = cvt_pk_bf16(b[2], b[3]); return w; }
__device__ __forceinline__ void unpack8(const u32x4& w, float (&v)[8]) { v[0] = bf_lo(w.x); v[1] = bf_hi(w.x); v[2] = bf_lo(w.y); v[3] = bf_hi(w.y); v[4] = bf_lo(w.z); v[5] = bf_hi(w.z); v[6] = bf_lo(w.w); v[7] = bf_hi(w.w); }

__device__ __forceinline__ float row_inv16(const float* p16, float invn) {
    const f32x4 a = ((const f32x4*)p16)[0], b = ((const f32x4*)p16)[1], c = ((const f32x4*)p16)[2], d = ((const f32x4*)p16)[3];
    const float s = ((a[0] + a[1]) + (a[2] + a[3])) + ((b[0] + b[1]) + (b[2] + b[3])) + ((c[0] + c[1]) + (c[2] + c[3])) + ((d[0] + d[1]) + (d[2] + d[3]));
    return 1.0f / sqrtf(s * invn + EPS);
}
struct FIn {
    bf16_t* proj; bf16_t* krope; const float* ssqh; float* ssqq; float* ssqkv;
    struct Ld { f32x4 p[4]; };
    __device__ __forceinline__ void load(Ld& d, int row, int, int, int) const {
#pragma unroll
        for (int i = 0; i < 4; ++i) d.p[i] = ((const f32x4*)(ssqh + (size_t)row * 16))[i]; }
    __device__ __forceinline__ void apply(const Ld& d, int row, int c0, int pn, int wc, int fq, const f32x4& a0, const f32x4& b0, const f32x4& a1, const f32x4& b1) const {
        const f32x4 t = (d.p[0] + d.p[1]) + (d.p[2] + d.p[3]);
        const float inv = __builtin_amdgcn_rsqf(((t[0] + t[1]) + (t[2] + t[3])) * (1.f / DM) + EPS);
        const f32x4 v0 = a0 * inv, v1 = b0 * inv, v2 = a1 * inv, v3 = b1 * inv;
        if (pn < 18) { *(u32x4*)(proj + (size_t)row * PW + c0) = pack8(v0, v1); *(u32x4*)(proj + (size_t)row * PW + c0 + 128) = pack8(v2, v3); }
        else if (c0 < 4608 + 32) *(u32x4*)(krope + (size_t)row * 32 + (c0 - 4608)) = pack8(v0, v1);
        if (pn >= 4 && pn < 8) {
            const f32x4 sq = v0 * v0 + v1 * v1 + v2 * v2 + v3 * v3; float ss = (sq[0] + sq[1]) + (sq[2] + sq[3]);
            ss += xor16f(ss); ss += xor32f(ss);
            if (fq == 0) { if (pn < 7) ssqq[(size_t)row * 12 + (pn - 4) * 4 + wc] = ss; else ssqkv[(size_t)row * 4 + wc] = ss; }
        }
    }
};
struct FQ {
    bf16_t* o; const float* ssqq;
    struct Ld { f32x4 p[3]; };
    __device__ __forceinline__ void load(Ld& d, int row, int, int, int) const {
#pragma unroll
        for (int i = 0; i < 3; ++i) d.p[i] = ((const f32x4*)(ssqq + (size_t)row * 12))[i]; }
    __device__ __forceinline__ void apply(const Ld& d, int row, int c0, int, int, int, const f32x4& a0, const f32x4& b0, const f32x4& a1, const f32x4& b1) const {
        const f32x4 t = d.p[0] + d.p[1] + d.p[2];
        const float inv = __builtin_amdgcn_rsqf(((t[0] + t[1]) + (t[2] + t[3])) * (1.f / 768.f) + EPS);
        *(u32x4*)(o + (size_t)row * 768 + c0) = pack8(a0 * inv, b0 * inv); *(u32x4*)(o + (size_t)row * 768 + c0 + 128) = pack8(a1 * inv, b1 * inv); }
};
struct FKV {
    bf16_t* Kb; const bf16_t* krope; const float* rope; const float* ssqkv; const float* gk;
    struct Ld { f32x4 pp, cs, sn; u32x2 r1, r2; };
    __device__ __forceinline__ void load(Ld& d, int row, int, int, int fq) const {
        d.pp = *(const f32x4*)(ssqkv + (size_t)row * 4);
        d.r1 = *(const u32x2*)(krope + (size_t)row * 32 + 4 * fq); d.r2 = *(const u32x2*)(krope + (size_t)row * 32 + 16 + 4 * fq);
        d.cs = *(const f32x4*)(rope + (size_t)row * 32 + 4 * fq); d.sn = *(const f32x4*)(rope + (size_t)row * 32 + 16 + 4 * fq); }
    __device__ __forceinline__ void apply(const Ld& d, int row, int, int pn, int wc, int fq, const f32x4& a0, const f32x4& b0, const f32x4& a1, const f32x4& b1) const {
        const float akv = __builtin_amdgcn_rsqf(((d.pp[0] + d.pp[1]) + (d.pp[2] + d.pp[3])) * (1.f / 256.f) + EPS);
        const f32x4 v0 = a0 * akv, v1 = b0 * akv, v2 = a1 * akv, v3 = b1 * akv;
        const int h = 4 * pn + wc, b = row / LP, p = row - b * LP;
        const f32x4 x1 = (f32x4){bf_lo(d.r1.x), bf_hi(d.r1.x), bf_lo(d.r1.y), bf_hi(d.r1.y)}, x2 = (f32x4){bf_lo(d.r2.x), bf_hi(d.r2.x), bf_lo(d.r2.y), bf_hi(d.r2.y)};
        const f32x4 sq = v0 * v0 + v1 * v1 + v2 * v2 + v3 * v3 + x1 * x1 + x2 * x2;
        float ss = (sq[0] + sq[1]) + (sq[2] + sq[3]);
        ss += xor16f(ss); ss += xor32f(ss);
        const float inv = __builtin_amdgcn_rsqf(ss * (1.f / 96.f) + EPS);
        const f32x4 g0 = *(const f32x4*)(gk + 8 * fq), g1 = *(const f32x4*)(gk + 8 * fq + 4), g2 = *(const f32x4*)(gk + 32 + 8 * fq), g3 = *(const f32x4*)(gk + 32 + 8 * fq + 4);
        const f32x4 gr1 = *(const f32x4*)(gk + 64 + 4 * fq), gr2 = *(const f32x4*)(gk + 80 + 4 * fq);
        bf16_t* dst = Kb + ((size_t)(b * NH + h) * LP + p) * 96;
        *(u32x4*)(dst + 8 * fq) = pack8(v0 * inv * g0, v1 * inv * g1);
        *(u32x4*)(dst + 32 + 8 * fq) = pack8(v2 * inv * g2, v3 * inv * g3);
        const f32x4 y1 = x1 * inv * gr1, y2 = x2 * inv * gr2;
        const f32x4 o1 = y1 * d.cs - y2 * d.sn, o2 = y2 * d.cs + y1 * d.sn;
        u32x2 w1, w2; w1.x = cvt_pk_bf16(o1[0], o1[1]); w1.y = cvt_pk_bf16(o1[2], o1[3]); w2.x = cvt_pk_bf16(o2[0], o2[1]); w2.y = cvt_pk_bf16(o2[2], o2[3]);
        *(u32x2*)(dst + 64 + 4 * fq) = w1; *(u32x2*)(dst + 80 + 4 * fq) = w2;
    }
};
struct FPoolUp {
    bf16_t* proj;
    struct Ld { u32x4 g0, g1; };
    __device__ __forceinline__ void load(Ld& d, int row, int c0, int, int) const { d.g0 = *(const u32x4*)(proj + (size_t)row * PW + C_GP + c0); d.g1 = *(const u32x4*)(proj + (size_t)row * PW + C_GP + c0 + 128); }
    __device__ __forceinline__ void half(const u32x4& gw, int row, int col, const f32x4& a, const f32x4& b) const {
        float g[8]; unpack8(gw, g);
        f32x4 r0, r1;
#pragma unroll
        for (int i = 0; i < 4; ++i) { r0[i] = a[i] * sigmoidf_(g[i]); r1[i] = b[i] * sigmoidf_(g[4 + i]); }
        *(u32x4*)(proj + (size_t)row * PW + C_MPOOL + col) = pack8(r0, r1);
    }
    __device__ __forceinline__ void apply(const Ld& d, int row, int c0, int, int, int, const f32x4& a0, const f32x4& b0, const f32x4& a1, const f32x4& b1) const { half(d.g0, row, c0, a0, b0); half(d.g1, row, c0 + 128, a1, b1); }
};
struct FMlaUp {
    const bf16_t* proj; bf16_t* merged;
    struct Ld { u32x4 g0, g1, p0, p1; };
    __device__ __forceinline__ void load(Ld& d, int row, int c0, int, int) const {
        d.g0 = *(const u32x4*)(proj + (size_t)row * PW + C_GM + c0); d.g1 = *(const u32x4*)(proj + (size_t)row * PW + C_GM + c0 + 128);
        d.p0 = *(const u32x4*)(proj + (size_t)row * PW + C_MPOOL + c0); d.p1 = *(const u32x4*)(proj + (size_t)row * PW + C_MPOOL + c0 + 128); }
    __device__ __forceinline__ void half(const u32x4& gw, const u32x4& pw, int row, int col, const f32x4& a, const f32x4& b) const {
        float g[8]; unpack8(gw, g); float p[8]; unpack8(pw, p);
        f32x4 r0, r1;
#pragma unroll
        for (int i = 0; i < 4; ++i) { r0[i] = a[i] * sigmoidf_(g[i]) + p[i]; r1[i] = b[i] * sigmoidf_(g[4 + i]) + p[4 + i]; }
        *(u32x4*)(merged + (size_t)row * 1024 + col) = pack8(r0, r1);
    }
    __device__ __forceinline__ void apply(const Ld& d, int row, int c0, int, int, int, const f32x4& a0, const f32x4& b0, const f32x4& a1, const f32x4& b1) const { half(d.g0, d.p0, row, c0, a0, b0); half(d.g1, d.p1, row, c0 + 128, a1, b1); }
};
__device__ __forceinline__ float* hres_row(float* out, float* metah, int row) {
    const int b = row / LP, t = row - b * LP - PADF;
    if (t < 0) return nullptr;
    if (t < NMETA) return metah + (size_t)(b * NMETA + t) * DM;
    return out + ((size_t)b * SEQ + (t - NMETA)) * DM;
}
struct FOut {
    float* out; float* metah; bf16_t* hb; float* ssqh; const float* xin; const float* metain;
    struct Ld { f32x4 v[4]; };
    __device__ __forceinline__ void load(Ld& d, int row, int c0, int, int) const {
        const int b = row / LP, t = row - b * LP - PADF;
        const f32x4 z = (f32x4){0.f, 0.f, 0.f, 0.f}; d.v[0] = z; d.v[1] = z; d.v[2] = z; d.v[3] = z;
        if (t >= 0) { const float* sr = xin ? ((t < NMETA) ? metain + (size_t)t * DM : xin + ((size_t)b * SEQ + (t - NMETA)) * DM) : hres_row(out, metah, row);
            d.v[0] = *(const f32x4*)(sr + c0); d.v[1] = *(const f32x4*)(sr + c0 + 4); d.v[2] = *(const f32x4*)(sr + c0 + 128); d.v[3] = *(const f32x4*)(sr + c0 + 132); }
    }
    __device__ __forceinline__ void apply(const Ld& d, int row, int c0, int pn, int wc, int fq, const f32x4& a0, const f32x4& b0, const f32x4& a1, const f32x4& b1) const {
        float* r = hres_row(out, metah, row);
        f32x4 v0 = (f32x4){0.f, 0.f, 0.f, 0.f}, v1 = v0, v2 = v0, v3 = v0;
        if (r) { v0 = d.v[0] + a0; v1 = d.v[1] + b0; v2 = d.v[2] + a1; v3 = d.v[3] + b1;
            *(f32x4*)(r + c0) = v0; *(f32x4*)(r + c0 + 4) = v1; *(f32x4*)(r + c0 + 128) = v2; *(f32x4*)(r + c0 + 132) = v3; }
        if (!hb) return;
        *(u32x4*)(hb + (size_t)row * DM + c0) = pack8(v0, v1); *(u32x4*)(hb + (size_t)row * DM + c0 + 128) = pack8(v2, v3);
        const f32x4 sq = v0 * v0 + v1 * v1 + v2 * v2 + v3 * v3;
        float ss = (sq[0] + sq[1]) + (sq[2] + sq[3]);
        ss += xor16f(ss); ss += xor32f(ss);
        if (fq == 0) ssqh[(size_t)row * 16 + 4 * pn + wc] = ss;
    }
};
enum { K_IN = 0, K_Q = 1, K_KV = 2, K_POOLUP = 3, K_MLAUP = 4, K_OUT = 5, K_VT = 6 };
struct EpiAll {
    int kind; unsigned char* ws; float* out; const float* gk; const float* xin; const float* metain; int last;
    __device__ __forceinline__ void operator()(const f32x4 (&acc)[2][2][4][2], const pg8::Unit& u, int wr, int wc, int fr, int fq) const {
        bf16_t* proj = (bf16_t*)(ws + WS_PROJ);
        switch (kind) {
            case K_IN:     { pg8::Epi<FIn> e{{proj, (bf16_t*)(ws + WS_KROPE), (const float*)(ws + WS_SSQH), (float*)(ws + WS_SSQQ), (float*)(ws + WS_SSQKV)}}; e(acc, u, wr, wc, fr, fq); } break;
            case K_Q:      { pg8::Epi<FQ> e{{(bf16_t*)(ws + WS_QRAW), (const float*)(ws + WS_SSQQ)}}; e(acc, u, wr, wc, fr, fq); } break;
            case K_KV:     { pg8::Epi<FKV> e{{(bf16_t*)(ws + WS_H), (const bf16_t*)(ws + WS_KROPE), (const float*)(ws + WS_ROPE), (const float*)(ws + WS_SSQKV), gk}}; e(acc, u, wr, wc, fr, fq); } break;
            case K_VT: {
                bf16_t* vt = (bf16_t*)(ws + WS_V); const float* ssqkv = (const float*)(ws + WS_SSQKV);
                const int c0 = u.pn * pg8::BM + wc * 32 + 8 * fq; float sc[2][8];
#pragma unroll
                for (int hf = 0; hf < 2; ++hf)
#pragma unroll
                    for (int i = 0; i < 8; ++i) { const f32x4 pp = *(const f32x4*)(ssqkv + (size_t)(c0 + 128 * hf + i) * 4); sc[hf][i] = __builtin_amdgcn_rsqf(((pp[0] + pp[1]) + (pp[2] + pp[3])) * (1.f / 256.f) + EPS); }
#pragma unroll
                for (int ai = 0; ai < 2; ++ai)
#pragma unroll
                    for (int m = 0; m < 4; ++m) { bf16_t* d = vt + (size_t)(u.pm * pg8::BM + ai * pg8::HALF + wr * 64 + m * 16 + fr) * MP + c0;
#pragma unroll
                        for (int hf = 0; hf < 2; ++hf) { f32x4 x = acc[ai][hf][m][0], y = acc[ai][hf][m][1];
#pragma unroll
                            for (int i = 0; i < 4; ++i) { x[i] *= sc[hf][i]; y[i] *= sc[hf][4 + i]; }
                            *(u32x4*)(d + 128 * hf) = pack8(x, y); }
                        asm volatile("" ::: "memory"); }
            } break;
            case K_POOLUP: { pg8::Epi<FPoolUp> e{{proj}}; e(acc, u, wr, wc, fr, fq); } break;
            case K_MLAUP:  { pg8::Epi<FMlaUp> e{{proj, (bf16_t*)(ws + WS_QRAW)}}; e(acc, u, wr, wc, fr, fq); } break;
            default:       { pg8::Epi<FOut> e{{out, (float*)(ws + WS_METAH), last ? nullptr : (bf16_t*)(ws + WS_H), (float*)(ws + WS_SSQH), xin, metain}}; e(acc, u, wr, wc, fr, fq); } break;
        }
    }
};

__device__ __forceinline__ void tr_item(const float* W, int ldw, int k0, int n0, bf16_t* WT, int ldt, int drow0, int dk0, LAS float* scr, int lane, const float* kgain = nullptr) {
#pragma unroll 8
    for (int i = 0; i < 32; ++i) { const int kk = 2 * i + (lane >> 5); float w = W[(size_t)(k0 + kk) * ldw + n0 + (lane & 31)]; if (kgain) w *= kgain[k0 + kk]; scr[kk * 33 + (lane & 31)] = w; }
    LDS_WAIT(); asm volatile("" ::: "memory");
    const int c = lane & 7;
#pragma unroll
    for (int j = 0; j < 4; ++j) { const int n = (lane >> 3) + 8 * j; const LAS float* s = scr + (8 * c) * 33 + n;
        u32x4 o; o.x = cvt_pk_bf16(s[0 * 33], s[1 * 33]); o.y = cvt_pk_bf16(s[2 * 33], s[3 * 33]); o.z = cvt_pk_bf16(s[4 * 33], s[5 * 33]); o.w = cvt_pk_bf16(s[6 * 33], s[7 * 33]);
        *(u32x4*)(WT + (size_t)(drow0 + n) * ldt + dk0 + 8 * c) = o; }
    LDS_WAIT(); asm volatile("" ::: "memory");
}
__device__ __forceinline__ void wcomb_item(const float* w_in, const float* wg, const float* ngain, bf16_t* WinT, int item, int lane) {
    const int g = item >> 8, kb = (item >> 2) & 63, db = item & 3, kk = lane >> 2, dq = lane & 3, k = kb * 16 + kk, d0 = db * 32 + 8 * dq;
    const float* ap = w_in + (size_t)k * DIN + 128 * g; const float* bp = wg + (size_t)g * 128 * 128 + d0;
    f32x4 c0 = (f32x4){0.f, 0.f, 0.f, 0.f}, c1 = c0;
#pragma unroll 4
    for (int cin = 0; cin < 128; ++cin) { const float av = ap[cin]; const f32x4 b0 = *(const f32x4*)(bp + (size_t)cin * 128), b1 = *(const f32x4*)(bp + (size_t)cin * 128 + 4); c0 += b0 * av; c1 += b1 * av; }
    const float gn = ngain[k];
    bf16_t* o = WinT + (size_t)(128 * g + d0) * 1024 + k;
#pragma unroll
    for (int i = 0; i < 4; ++i) { o[(size_t)i * 1024] = (bf16_t)(cvt_pk_bf16(c0[i] * gn, 0.f) & 0xffffu); o[(size_t)(4 + i) * 1024] = (bf16_t)(cvt_pk_bf16(c1[i] * gn, 0.f) & 0xffffu); }
}
constexpr int CW_I_C = 1024, CW_I_IN = 16 * 129, CW_I_Z = 28, CW_FIRST = CW_I_C + CW_I_IN + CW_I_Z;
__device__ __forceinline__ void convert_weights(const Args& a, int l, LAS unsigned char* lds, unsigned* ctr, int wave, int lane, int lo, int hi, int sgw = 0, int sngw = 1) {
    LAS float* scr = (LAS float*)(lds + wave * 16384);
    unsigned char* wb = a.ws + WS_W;
    bf16_t* WinT = (bf16_t*)(wb + W_IN); bf16_t* WqT = (bf16_t*)(wb + W_Q); bf16_t* WkvT = (bf16_t*)(wb + W_KV);
    bf16_t* WpuT = (bf16_t*)(wb + W_PU); bf16_t* WmuT = (bf16_t*)(wb + W_MU); bf16_t* WoT = (bf16_t*)(wb + W_O + (size_t)(l & 1) * 1024 * 1024 * 2);
    const float* w_in = a.w_in + (size_t)l * 1024 * DIN; const float* w_g = a.pool_wg + (size_t)l * 4 * 128 * 128; const float* w_pu = a.pool_wu + (size_t)l * 512 * 1024;
    const float* w_qb = a.w_qb + (size_t)l * 768 * 768; const float* w_kvb = a.w_kvb + (size_t)l * 256 * 1024; const float* w_mu = a.mla_wu + (size_t)l * 512 * 1024; const float* w_o = a.w_out + (size_t)l * 1024 * 1024;
    const float* ngain = a.norm_gain + (size_t)l * DM;
    constexpr int I_C = 1024, I_IN = 16 * 129, I_Q = 12 * 24, I_KV = 4 * 32, I_PU = 8 * 32, I_MU = 8 * 32, I_O = 16 * 32;
    constexpr int I_Z = 28; static_assert(I_C == CW_I_C && I_IN == CW_I_IN && I_Z == CW_I_Z, "item map");
    int sidx = sgw;
    for (;;) {
        int it = 0;
        if (ctr) { if (lane == 0) it = (int)__hip_atomic_fetch_add(ctr, 1u, __ATOMIC_RELAXED, __HIP_MEMORY_SCOPE_AGENT); it = __builtin_amdgcn_readfirstlane(it); }
        else { it = sidx; sidx += sngw; }
        it += lo;
        if (it >= hi) break;
        int r = it;
        if (r < I_C) { wcomb_item(w_in, w_g, ngain, WinT, r, lane); continue; } r -= I_C;
        if (r < I_IN) { const int kb = r / 129, nb = r % 129 + 16, n0 = nb * 32; const int d = (n0 < 2048) ? n0 : (n0 < 2080 ? 4608 : n0 - 32);
            tr_item(w_in, DIN, kb * 64, n0, WinT, 1024, d, kb * 64, scr, lane, ngain); continue; } r -= I_IN;
        if (r < I_Z) { u32x4* z = (u32x4*)(WinT + (size_t)4640 * 1024) + (size_t)r * 1024 + lane; const u32x4 zz = zero4();
#pragma unroll
            for (int i = 0; i < 16; ++i) z[64 * i] = zz;
            continue; } r -= I_Z;
        if (r < I_Q) { const int kb = r / 24, nb = r % 24; tr_item(w_qb, 768, kb * 64, nb * 32, WqT, 768, nb * 32, kb * 64, scr, lane, a.qa_gain + (size_t)l * 768); continue; } r -= I_Q;
        if (r < I_KV) { const int kb = r / 32, nb = r % 32, h = nb >> 2, q = nb & 3;
            const int d = (q < 2) ? 256 * (h >> 2) + 128 * q + 32 * (h & 3) : 512 + h * 64 + 32 * (q - 2);
            tr_item(w_kvb, 1024, kb * 64, nb * 32, WkvT, 256, d, kb * 64, scr, lane, a.kva_gain + (size_t)l * 256); continue; } r -= I_KV;
        if (r < I_PU) { const int kb = r / 32, nb = r % 32; tr_item(w_pu, 1024, kb * 64, nb * 32, WpuT, 512, nb * 32, kb * 64, scr, lane); continue; } r -= I_PU;
        if (r < I_MU) { const int kb = r / 32, nb = r % 32; tr_item(w_mu, 1024, kb * 64, nb * 32, WmuT, 512, nb * 32, kb * 64, scr, lane); continue; } r -= I_MU;
        { const int kb = r / 32, nb = r % 32; tr_item(w_o, 1024, kb * 64, nb * 32, WoT, 1024, nb * 32, kb * 64, scr, lane); }
    }
}

constexpr int CW_NITEMS = CW_FIRST + 12 * 24 + 4 * 32 + 8 * 32 + 8 * 32 + 16 * 32;
__device__ __forceinline__ void row_to_hb(const float* src, bf16_t* dst, float* ssq16, int lane) {
    unsigned long long* o8 = (unsigned long long*)dst + lane;
    float s = 0.f;
    if (!src) {
#pragma unroll
        for (int j = 0; j < 4; ++j) o8[64 * j] = 0ull;
    } else {
        const f32x4* xr = (const f32x4*)src + lane;
#pragma unroll
        for (int j = 0; j < 4; ++j) { const f32x4 v = xr[64 * j]; s += (v.x * v.x + v.y * v.y) + (v.z * v.z + v.w * v.w);
            o8[64 * j] = (unsigned long long)cvt_pk_bf16(v.x, v.y) | ((unsigned long long)cvt_pk_bf16(v.z, v.w) << 32); }
        s = wave_sum(s);
    }
    if (lane < 16) ssq16[lane] = (lane == 0) ? s : 0.f;
}

__constant__ double c_inv_freq[16] = {1.0, 0.5623413251903491, 0.31622776601683794, 0.1778279410038923, 0.1, 0.05623413251903491, 0.03162277660168379, 0.01778279410038923,
                                       0.01, 0.005623413251903491, 0.0031622776601683794, 0.0017782794100389228, 0.001, 0.0005623413251903491, 0.00031622776601683794, 0.00017782794100389227};
__device__ __forceinline__ void sincos_d(double ang, float& c, float& s) {
    const double k = rint(ang * 0.6366197723675814); const double y = fma(-k, 6.123233995736766e-17, fma(-k, 1.5707963267948966, ang));
    const double y2 = y * y;
    const double sn = y * (1.0 - y2 / 6.0 * (1.0 - y2 / 20.0 * (1.0 - y2 / 42.0 * (1.0 - y2 / 72.0 * (1.0 - y2 / 110.0 * (1.0 - y2 / 156.0))))));
    const double cs = 1.0 - y2 / 2.0 * (1.0 - y2 / 12.0 * (1.0 - y2 / 30.0 * (1.0 - y2 / 56.0 * (1.0 - y2 / 90.0 * (1.0 - y2 / 132.0 * (1.0 - y2 / 182.0))))));
    const int q = ((int)(long long)k) & 3;
    const double cc = (q == 0) ? cs : (q == 1) ? -sn : (q == 2) ? -cs : sn;
    const double ss = (q == 0) ? sn : (q == 1) ? cs : (q == 2) ? -sn : -cs;
    c = (float)cc; s = (float)ss;
}

__device__ __forceinline__ void phase_init(const Args& a, LAS unsigned char* lds, int vcu, int NGW, int wv) {
    const int tid = opaque_tid(wv), lane = tid & 63, wave = __builtin_amdgcn_readfirstlane(tid >> 6), gw = vcu * 8 + wave;
    bf16_t* H = (bf16_t*)(a.ws + WS_H); float* metah = (float*)(a.ws + WS_METAH); float* rope = (float*)(a.ws + WS_ROPE);
    for (int m0 = gw; m0 < MP; m0 += 2 * NGW) {
        f32x4 v[2][4]; const float* srcs[2];
#pragma unroll
        for (int k = 0; k < 2; ++k) { const int m = m0 + k * NGW; srcs[k] = nullptr;
            if (m < MP) { const int b = m / LP, t = m - b * LP - PADF;
                srcs[k] = (t < 0) ? nullptr : (t < NMETA ? a.meta + (size_t)t * DM : a.x + ((size_t)b * SEQ + (t - NMETA)) * DM); }
            if (srcs[k]) {
#pragma unroll
                for (int j = 0; j < 4; ++j) v[k][j] = ((const f32x4*)srcs[k] + lane)[64 * j]; }
            else {
#pragma unroll
                for (int j = 0; j < 4; ++j) v[k][j] = (f32x4){0.f, 0.f, 0.f, 0.f}; } }
#pragma unroll
        for (int k = 0; k < 2; ++k) { const int m = m0 + k * NGW; if (m >= MP) break;
            const int b = m / LP, t = m - b * LP - PADF;
            unsigned long long* o8 = (unsigned long long*)(H + (size_t)m * DM) + lane; float ssum = 0.f;
#pragma unroll
            for (int j = 0; j < 4; ++j) { const f32x4 x = v[k][j]; ssum += (x.x * x.x + x.y * x.y) + (x.z * x.z + x.w * x.w);
                o8[64 * j] = (unsigned long long)cvt_pk_bf16(x.x, x.y) | ((unsigned long long)cvt_pk_bf16(x.z, x.w) << 32); }
            ssum = wave_sum(ssum);
            if (lane < 16) ((float*)(a.ws + WS_SSQH) + (size_t)m * 16)[lane] = (lane == 0) ? ssum : 0.f;
            if (lane < 16) {
                float c = 1.f, sn = 0.f;
                if (t >= 0) { const int p = (t < NMETA) ? t : a.pos[b * SEQ + (t - NMETA)] + NMETA; sincos_d((double)p * c_inv_freq[lane], c, sn); }
                rope[(size_t)m * 32 + lane] = c; rope[(size_t)m * 32 + 16 + lane] = sn;
            }
        }
    }
    { unsigned* ctl = (unsigned*)(a.ws + WS_CTL);
      const int i = gw * 64 + lane; if (i < (int)(CTL_ZERO_BYTES / 4)) ctl[i] = 0u; }
    convert_weights(a, 0, lds, nullptr, wave, lane, 0, CW_FIRST, gw, NGW);
}

__device__ __forceinline__ void phase_pool(const Args& a, int l, int vcu, int NGW, int wv) {
    const int tid = opaque_tid(wv), lane = tid & 63, wave = __builtin_amdgcn_readfirstlane(tid >> 6), gw = vcu * 8 + wave;
    bf16_t* proj = (bf16_t*)(a.ws + WS_PROJ);
    const float* sc = a.pool_scale + (size_t)l * 512 + 8 * lane;
    const f32x4 sc0 = *(const f32x4*)sc, sc1 = *(const f32x4*)(sc + 4);
    const int g = lane >> 4, w = 2 << g;
    constexpr int CR = 17, CPB = (LP + CR - 1) / CR;
    for (int ch = gw; ch < BATCH * CPB; ch += NGW) {
        const int bb = ch / CPB, p0 = (ch - bb * CPB) * CR, r0 = bb * LP + p0, nrows = (LP - p0 < CR) ? LP - p0 : CR;
        if (p0 + CR <= PADF) {
            const u32x4 zz = zero4();
            for (int i = 0; i < nrows; ++i) *(u32x4*)(proj + (size_t)(r0 + i) * PW + C_P1Y + 8 * lane) = zz;
            continue; }
        float S[8];
#pragma unroll
        for (int i = 0; i < 8; ++i) S[i] = 0.f;
        for (int j = 1; j < w; ++j) { const u32x4 uw = *(const u32x4*)(proj + (size_t)(r0 - j) * PW + C_U + 8 * lane); float u[8]; unpack8(uw, u);
#pragma unroll
            for (int i = 0; i < 8; ++i) S[i] += u[i]; }
#pragma unroll 2
        for (int i = 0; i < nrows; ++i) {
            const int m = r0 + i, t = p0 + i - PADF;
            bf16_t* prow = proj + (size_t)m * PW;
            const u32x4 uw = *(const u32x4*)(prow + C_U + 8 * lane); float u[8]; unpack8(uw, u);
            const u32x4 zw = *(const u32x4*)(prow + C_Z + 8 * lane); float z[8]; unpack8(zw, z);
            const u32x4 ow = *(const u32x4*)(proj + (size_t)(m - (w - 1)) * PW + C_U + 8 * lane); float o[8]; unpack8(ow, o);
#pragma unroll
            for (int k = 0; k < 8; ++k) S[k] += u[k];
            f32x4 r0v = (f32x4){0.f, 0.f, 0.f, 0.f}, r1v = r0v;
            if (t >= 0) { const int cnt = (t + 1 < w) ? (t + 1) : w; const float ic = 1.0f / (float)cnt;
#pragma unroll
                for (int k = 0; k < 4; ++k) { r0v[k] = (S[k] * ic - u[k]) * sc0[k] * siluf_(z[k]); r1v[k] = (S[4 + k] * ic - u[4 + k]) * sc1[k] * siluf_(z[4 + k]); } }
            *(u32x4*)(prow + C_P1Y + 8 * lane) = pack8(r0v, r1v);
#pragma unroll
            for (int k = 0; k < 8; ++k) S[k] -= o[k];
        }
    }
}

constexpr int KPITCH = 208, VPITCH = 144, KBUF = 64 * KPITCH, VBUF = 64 * VPITCH;
constexpr float QSCALE = 0.1472444460259031f;
constexpr float MASKV = -1e30f;
__device__ __forceinline__ int kvmap(int r, int hi) { return 8 * hi + r + ((r >= 8) ? 8 : 0); }

__device__ __forceinline__ void attn_unit(const Args& a, int l, int b, int h, int R0, bool special, LAS unsigned char* lds, float kb, int wv) {
    const int tid = opaque_tid(wv), lane = tid & 63, wave = __builtin_amdgcn_readfirstlane(tid >> 6), r32 = lane & 31, hi = lane >> 5;
    const bf16_t* qraw = (const bf16_t*)(a.ws + WS_QRAW); const bf16_t* Kb = (const bf16_t*)(a.ws + WS_H); const bf16_t* Vb = (const bf16_t*)(a.ws + WS_V);
    const float* rope = (const float*)(a.ws + WS_ROPE); bf16_t* proj = (bf16_t*)(a.ws + WS_PROJ);
    const float* gq = a.qn_gain + (size_t)l * 96;
    const int qp = R0 + 32 * wave + r32;
    const int mq = b * LP + qp;
    const int TL = special ? 1 : (R0 + 255) / 64;
    const int qmin = R0 + 32 * wave;
    const int tw = (qmin + 31) / 64 < TL ? (qmin + 31) / 64 : TL;
    const bf16_t* Kh = Kb + (size_t)(b * NH + h) * LP * 96;
    LAS unsigned char* KB0 = lds; LAS unsigned char* VB0 = lds + 4 * KBUF;
    int kofs[2], vofs[2];
#pragma unroll
    for (int i = 0; i < 2; ++i) { const int ck = (wave + 8 * i) * 64 + lane, rk = ck / 13, qk = ck - rk * 13; kofs[i] = rk * 96 + (qk < 12 ? qk : 11) * 8;
        const int cv = (i == 0 ? wave : 8) * 64 + lane, rv = cv / 9, qv = cv - rv * 9; vofs[i] = rv * MP + (qv < 8 ? qv : 7) * 8; }
    const bf16_t* Vh = Vb + (size_t)(h * 64) * MP + (size_t)b * LP;
    const int nis = 2 + (wave < 5 ? 1 : 0) + (wave == 0 ? 1 : 0);
#define ATT_DMAK(t) do { const bf16_t* kt = Kh + (size_t)(t) * 64 * 96; LAS unsigned char* kb = KB0 + ((t) & 3) * KBUF; \
        __builtin_amdgcn_global_load_lds((const unsigned*)(kt + kofs[0]), (LAS unsigned*)(kb + wave * 1024), 16, 0, 0); \
        if (wave < 5) __builtin_amdgcn_global_load_lds((const unsigned*)(kt + kofs[1]), (LAS unsigned*)(kb + (wave + 8) * 1024), 16, 0, 0); } while (0)
#define ATT_DMAV(t) do { const bf16_t* vt = Vh + (t) * 64; LAS unsigned char* vb = VB0 + ((t) % 3) * VBUF; \
        __builtin_amdgcn_global_load_lds((const unsigned*)(vt + vofs[0]), (LAS unsigned*)(vb + wave * 1024), 16, 0, 0); \
        if (wave == 0) __builtin_amdgcn_global_load_lds((const unsigned*)(vt + vofs[1]), (LAS unsigned*)(vb + 8 * 1024), 16, 0, 0); } while (0)
    LAS unsigned char* QST = lds + 81920 + wave * 6144;
    LAS unsigned char* RST = (wave < 3) ? lds + wave * 4096 : (wave < 6) ? lds + 3 * KBUF + (wave - 3) * 4096 : lds + 4 * KBUF + (wave - 6) * 4096;
    { const int mq0 = b * LP + R0 + 32 * wave;
#pragma unroll
      for (int j = 0; j < 6; ++j) { const int c = j * 64 + lane, row = c / 12, piece = c - row * 12;
          __builtin_amdgcn_global_load_lds((const unsigned*)(qraw + (size_t)(mq0 + row) * 768 + h * 96 + piece * 8), (LAS unsigned*)(QST + j * 1024), 16, 0, 0); }
#pragma unroll
      for (int j = 0; j < 4; ++j)
          __builtin_amdgcn_global_load_lds((const unsigned*)(rope + (size_t)mq0 * 32 + (j * 64 + lane) * 4), (LAS unsigned*)(RST + j * 1024), 16, 0, 0); }
    ATT_DMAK(1); ATT_DMAV(1); ATT_DMAK(2);
    if (wave == 0) asm volatile("s_waitcnt vmcnt(6)" ::: "memory"); else if (wave < 5) asm volatile("s_waitcnt vmcnt(5)" ::: "memory"); else asm volatile("s_waitcnt vmcnt(3)" ::: "memory");
    bf16x8 qr[6]; float qnorm = 0.f;
    {
        float qf[6][8]; float ss = 0.f;
        const LAS unsigned char* qs = QST + r32 * 192 + hi * 16;
#pragma unroll
        for (int d0 = 0; d0 < 6; ++d0) { const u32x4 w = *(const LAS u32x4*)(qs + 32 * d0); unpack8(w, qf[d0]);
#pragma unroll
            for (int i = 0; i < 8; ++i) ss += qf[d0][i] * qf[d0][i]; }
        ss += xor32f(ss);
        const float inv = __builtin_amdgcn_rsqf(ss * (1.f / 96.f) + EPS);
#pragma unroll
        for (int d0 = 0; d0 < 6; ++d0) { const f32x4 g0 = *(const f32x4*)(gq + 16 * d0 + 8 * hi), g1 = *(const f32x4*)(gq + 16 * d0 + 8 * hi + 4);
#pragma unroll
            for (int i = 0; i < 4; ++i) { qf[d0][i] *= inv * g0[i]; qf[d0][4 + i] *= inv * g1[i]; } }
        const LAS unsigned char* cs = RST + r32 * 128 + hi * 32;
        const f32x4 c0 = *(const LAS f32x4*)(cs), c1 = *(const LAS f32x4*)(cs + 16), s0 = *(const LAS f32x4*)(cs + 64), s1 = *(const LAS f32x4*)(cs + 80);
#pragma unroll
        for (int i = 0; i < 8; ++i) { const float c = (i < 4) ? c0[i & 3] : c1[i & 3], s = (i < 4) ? s0[i & 3] : s1[i & 3]; const float x1 = qf[4][i], x2 = qf[5][i];
            qf[4][i] = x1 * c - x2 * s; qf[5][i] = x2 * c + x1 * s; }
        { float q2 = 0.f;
#pragma unroll
          for (int d0 = 0; d0 < 6; ++d0)
#pragma unroll
              for (int i = 0; i < 8; ++i) q2 += qf[d0][i] * qf[d0][i];
          q2 += xor32f(q2); qnorm = __builtin_amdgcn_sqrtf(q2) * QSCALE; }
#pragma unroll
        for (int d0 = 0; d0 < 6; ++d0) { u32x4 w; w.x = cvt_pk_bf16(qf[d0][0] * QSCALE, qf[d0][1] * QSCALE); w.y = cvt_pk_bf16(qf[d0][2] * QSCALE, qf[d0][3] * QSCALE);
            w.z = cvt_pk_bf16(qf[d0][4] * QSCALE, qf[d0][5] * QSCALE); w.w = cvt_pk_bf16(qf[d0][6] * QSCALE, qf[d0][7] * QSCALE); qr[d0] = __builtin_bit_cast(bf16x8, w); }
    }
    asm volatile("s_waitcnt vmcnt(0) lgkmcnt(0)" ::: "memory"); __builtin_amdgcn_s_barrier(); asm volatile("" ::: "memory");
    ATT_DMAK(3); ATT_DMAV(2);
    const int krow = kvmap((r32 & 3) + 4 * (r32 >> 3), (r32 >> 2) & 1);
    const int koff = krow * KPITCH + 16 * hi, voff = r32 * VPITCH + 16 * hi;
#define ATT_QK(P0, P1, t, C) do { const LAS unsigned char* kb = KB0 + ((t) & 3) * KBUF + koff; P0 = C; P1 = C; \
        _Pragma("unroll") for (int d0 = 0; d0 < 6; ++d0) { const bf16x8 ka = *(const LAS bf16x8*)(kb + 32 * d0), kc = *(const LAS bf16x8*)(kb + 32 * KPITCH + 32 * d0); \
            P0 = __builtin_amdgcn_mfma_f32_32x32x16_bf16(ka, qr[d0], P0, 0, 0, 0); P1 = __builtin_amdgcn_mfma_f32_32x32x16_bf16(kc, qr[d0], P1, 0, 0, 0); } } while (0)
#define ATT_MASK(P0, P1, t, PADCHK) do { _Pragma("unroll") for (int r = 0; r < 16; ++r) { const int kv = 64 * (t) + kvmap(r, hi); \
        if (!(kv <= qp && (!(PADCHK) || kv >= PADF))) P0[r] = MASKV; if (!(kv + 32 <= qp && (!(PADCHK) || kv + 32 >= PADF))) P1[r] = MASKV; } } while (0)
#define ATT_ROWMAX(P0, P1, RM) do { float a_ = fmaxf(fmaxf(P0[0], P0[1]), P1[0]), b_ = fmaxf(fmaxf(P0[2], P0[3]), P1[1]); a_ = fmaxf(fmaxf(a_, P1[2]), P1[3]); \
        _Pragma("unroll") for (int r = 4; r < 16; r += 4) { a_ = fmaxf(fmaxf(a_, P0[r]), P0[r + 1]); b_ = fmaxf(fmaxf(b_, P0[r + 2]), P0[r + 3]); a_ = fmaxf(fmaxf(a_, P1[r]), P1[r + 1]); b_ = fmaxf(fmaxf(b_, P1[r + 2]), P1[r + 3]); } \
        RM = fmaxf(a_, b_); RM = fmaxf(RM, xor32f(RM)); } while (0)
    const bool fixed = kb > 0.f;
    float mref = fixed ? kb * qnorm : 0.f, lsum = 0.f; f32x16 o0 = {}, o1 = {}, pc0 = {}, pc1 = {}, negm;
#pragma unroll
    for (int r = 0; r < 16; ++r) negm[r] = -mref;
    if (tw >= 1) {
        ATT_QK(pc0, pc1, 1, negm);
        ATT_MASK(pc0, pc1, 1, true);
        if (!fixed) {
            float rm; ATT_ROWMAX(pc0, pc1, rm);
            mref = (rm < -1e29f) ? 0.f : rm;
#pragma unroll
            for (int r = 0; r < 16; ++r) { pc0[r] -= mref; pc1[r] -= mref; negm[r] = -mref; }
        }
    }
#define ATT_EXPP(pc0, pc1) do { float ps = 0.f; \
        _Pragma("unroll") for (int r = 0; r < 16; ++r) { pc0[r] = __builtin_amdgcn_exp2f(pc0[r]); pc1[r] = __builtin_amdgcn_exp2f(pc1[r]); ps += pc0[r] + pc1[r]; } \
        lsum += ps; \
        { u32x4 w; w.x = cvtpk_s(pc0[0], pc0[1]); w.y = cvtpk_s(pc0[2], pc0[3]); w.z = cvtpk_s(pc0[4], pc0[5]); w.w = cvtpk_s(pc0[6], pc0[7]); pa[0] = __builtin_bit_cast(bf16x8, w); \
          w.x = cvtpk_s(pc0[8], pc0[9]); w.y = cvtpk_s(pc0[10], pc0[11]); w.z = cvtpk_s(pc0[12], pc0[13]); w.w = cvtpk_s(pc0[14], pc0[15]); pa[1] = __builtin_bit_cast(bf16x8, w); \
          w.x = cvtpk_s(pc1[0], pc1[1]); w.y = cvtpk_s(pc1[2], pc1[3]); w.z = cvtpk_s(pc1[4], pc1[5]); w.w = cvtpk_s(pc1[6], pc1[7]); pa[2] = __builtin_bit_cast(bf16x8, w); \
          w.x = cvtpk_s(pc1[8], pc1[9]); w.y = cvtpk_s(pc1[10], pc1[11]); w.z = cvtpk_s(pc1[12], pc1[13]); w.w = cvtpk_s(pc1[14], pc1[15]); pa[3] = __builtin_bit_cast(bf16x8, w); } } while (0)
#define ATT_EXP() ATT_EXPP(pc0, pc1)
#define ATT_LDV(t) do { const LAS unsigned char* vb = VB0 + ((t) % 3) * VBUF + voff; \
        _Pragma("unroll") for (int k = 0; k < 4; ++k) { vf[2 * k] = *(const LAS bf16x8*)(vb + 32 * k); vf[2 * k + 1] = *(const LAS bf16x8*)(vb + 32 * VPITCH + 32 * k); } } while (0)
#define ATT_PV() do { _Pragma("unroll") for (int k = 0; k < 4; ++k) { o0 = __builtin_amdgcn_mfma_f32_32x32x16_bf16(vf[2 * k], pa[k], o0, 0, 0, 0); o1 = __builtin_amdgcn_mfma_f32_32x32x16_bf16(vf[2 * k + 1], pa[k], o1, 0, 0, 0); } } while (0)
    if (wave >= 4) __builtin_amdgcn_s_setprio(1);
#define ATT_ISSUE(t) do { if ((t) + 3 <= TL) ATT_DMAK((t) + 3); if ((t) + 2 <= TL) ATT_DMAV((t) + 2); } while (0)
#define ATT_SYNC(t) do { if ((t) + 3 <= TL) { if (nis == 4) asm volatile("s_waitcnt vmcnt(4)" ::: "memory"); else if (nis == 3) asm volatile("s_waitcnt vmcnt(3)" ::: "memory"); else asm volatile("s_waitcnt vmcnt(2)" ::: "memory"); } \
        else asm volatile("s_waitcnt vmcnt(0)" ::: "memory"); \
        LDS_WAIT(); __builtin_amdgcn_s_barrier(); asm volatile("" ::: "memory"); } while (0)
#define ATT_BODY(t, C0, C1, N0, N1) do { ATT_ISSUE(t); \
        bf16x8 vf[8], pa[4]; \
        { const LAS unsigned char* kb_ = KB0 + (((t) + 1) & 3) * KBUF + koff; bf16x8 kf[6]; \
          _Pragma("unroll") for (int d0 = 0; d0 < 3; ++d0) { kf[2 * d0] = *(const LAS bf16x8*)(kb_ + 32 * d0); kf[2 * d0 + 1] = *(const LAS bf16x8*)(kb_ + 32 * KPITCH + 32 * d0); } \
          N0 = __builtin_amdgcn_mfma_f32_32x32x16_bf16(kf[0], qr[0], negm, 0, 0, 0); N1 = __builtin_amdgcn_mfma_f32_32x32x16_bf16(kf[1], qr[0], negm, 0, 0, 0); \
          _Pragma("unroll") for (int d0 = 1; d0 < 3; ++d0) { N0 = __builtin_amdgcn_mfma_f32_32x32x16_bf16(kf[2 * d0], qr[d0], N0, 0, 0, 0); N1 = __builtin_amdgcn_mfma_f32_32x32x16_bf16(kf[2 * d0 + 1], qr[d0], N1, 0, 0, 0); } \
          __builtin_amdgcn_sched_barrier(0); \
          _Pragma("unroll") for (int d0 = 3; d0 < 6; ++d0) { kf[2 * (d0 - 3)] = *(const LAS bf16x8*)(kb_ + 32 * d0); kf[2 * (d0 - 3) + 1] = *(const LAS bf16x8*)(kb_ + 32 * KPITCH + 32 * d0); } \
          _Pragma("unroll") for (int d0 = 3; d0 < 6; ++d0) { N0 = __builtin_amdgcn_mfma_f32_32x32x16_bf16(kf[2 * (d0 - 3)], qr[d0], N0, 0, 0, 0); N1 = __builtin_amdgcn_mfma_f32_32x32x16_bf16(kf[2 * (d0 - 3) + 1], qr[d0], N1, 0, 0, 0); } } \
        ATT_LDV(t); ATT_EXPP(C0, C1); ATT_PV(); \
        if (64 * ((t) + 1) + 63 > qmin) ATT_MASK(N0, N1, (t) + 1, false); \
        if (!fixed) { float rm; ATT_ROWMAX(N0, N1, rm); \
            if (__any(rm > 8.f)) { const float d = (rm > 8.f) ? rm : 0.f; const float f = __builtin_amdgcn_exp2f(-d); mref += d; lsum *= f; \
                _Pragma("unroll") for (int r = 0; r < 16; ++r) { N0[r] -= d; N1[r] -= d; negm[r] -= d; o0[r] *= f; o1[r] *= f; } } } \
        ATT_SYNC(t); } while (0)
#define ATT_TAIL(t, C0, C1) do { ATT_ISSUE(t); bf16x8 vf[8], pa[4]; ATT_LDV(t); ATT_EXPP(C0, C1); ATT_PV(); ATT_SYNC(t); } while (0)
    {
        f32x16 pb0, pb1; int t = 1;
        for (; t + 1 < tw; t += 2) { ATT_BODY(t, pc0, pc1, pb0, pb1); ATT_BODY(t + 1, pb0, pb1, pc0, pc1); }
        if (t < tw) { ATT_BODY(t, pc0, pc1, pb0, pb1); ++t; ATT_TAIL(t, pb0, pb1); ++t; }
        else if (t == tw) { ATT_TAIL(t, pc0, pc1); ++t; }
        for (; t <= TL; ++t) { ATT_ISSUE(t); ATT_SYNC(t); }
    }
    __builtin_amdgcn_s_setprio(0);
#undef ATT_ISSUE
#undef ATT_SYNC
#undef ATT_BODY
#undef ATT_TAIL
#undef ATT_EXPP
#undef ATT_EXP
#undef ATT_LDV
#undef ATT_PV
#undef ATT_DMAK
#undef ATT_DMAV
#undef ATT_QK
#undef ATT_MASK
#undef ATT_ROWMAX
    lsum += xor32f(lsum);
    const float il = (lsum > 0.f) ? 1.0f / lsum : 0.f;
    if (!(special && wave >= 4)) {
        bf16_t* prow = proj + (size_t)mq * PW + h * 64 + (hi ? 8 : 0);
#pragma unroll
        for (int db = 0; db < 2; ++db)
#pragma unroll
            for (int gp = 0; gp < 2; ++gp) {
                const f32x16& o = db ? o1 : o0;
                float v[8];
#pragma unroll
                for (int i = 0; i < 4; ++i) {
                    const auto rr = __builtin_amdgcn_permlane32_swap(__float_as_uint(o[8 * gp + i]), __float_as_uint(o[8 * gp + 4 + i]), false, false);
                    v[i] = __uint_as_float(rr[0]); v[4 + i] = __uint_as_float(rr[1]); }
                const int col = 32 * db + 16 * gp;
                const u32x4 zw = *(const u32x4*)(prow + C_ZM + col); float z[8]; unpack8(zw, z);
                f32x4 r0, r1;
#pragma unroll
                for (int i = 0; i < 4; ++i) { r0[i] = v[i] * il * siluf_(z[i]); r1[i] = v[4 + i] * il * siluf_(z[4 + i]); }
                *(u32x4*)(prow + C_OZ + col) = pack8(r0, r1);
            }
    }
}
__device__ __forceinline__ void phase_attn(const Args& a, int l, LAS unsigned char* lds, int vcu, int G, int wv) {
    float kb;
    { const float* gq = a.qn_gain + (size_t)l * 96; const float* gk = a.kn_gain + (size_t)l * 96;
      float mq = 0.f, mk = 0.f;
      for (int i = 0; i < 96; ++i) { mq = fmaxf(mq, fabsf(gq[i])); mk = fmaxf(mk, fabsf(gk[i])); }
      kb = 1.01f * 9.7979590f * mk;
      const float hi = kb * 9.7979590f * mq * QSCALE;
      if (!(hi < 48.f)) kb = -1.f; }
    const int sp0 = (G == 256) ? ((vcu >= 33 && vcu < 64) ? vcu - 33 : (vcu == 65 ? 31 : -1)) : (vcu < 32 ? vcu : -1);
    const int nmain = (vcu < 512) ? 2 * ((512 - vcu + G - 1) / G) : 0, nspec = (G == 256) ? (sp0 >= 0 ? 1 : 0) : ((vcu < 32) ? (32 - vcu + G - 1) / G : 0);
    for (int j = 0; j < nmain + nspec; ++j) {
        int b, h, R0; bool special;
        if (j < nmain) { const int it = vcu + (j >> 1) * G, bh = it >> 4, s = it & 15; b = bh >> 3; h = bh & 7; R0 = 128 + 256 * ((j & 1) ? s : 31 - s); special = false; }
        else { const int it = (G == 256) ? sp0 : vcu + (j - nmain) * G; b = it >> 3; h = it & 7; R0 = 0; special = true; }
        attn_unit(a, l, b, h, R0, special, lds, kb, wv);
    }
}

constexpr int NPHASE = 1 + 5 * DEPTH;
__global__ void __launch_bounds__(512, 2) trunk_fwd(Args a0) {
    extern __shared__ __attribute__((aligned(16))) unsigned char lds_raw[];
    LAS unsigned char* lds = (LAS unsigned char*)lds_raw;
    const int G = gridDim.x, bx = blockIdx.x;
    const int wv = __builtin_amdgcn_readfirstlane(threadIdx.x >> 6);
    const int vcu = (G % 8 == 0) ? (bx % 8) * (G / 8) + bx / 8 : bx;
    const int NGW = G * 8;
    for (int u = opaque_tid(wv); u < (LDS_BYTES - 131072) / 4; u += 512) ((LAS unsigned*)(lds + 131072))[u] = 0u;
    __syncthreads();
    XcdBarrier bar; bar.bar = (unsigned*)(a0.ws + WS_CTL) + 4096; bar.x = xb_xcc_id(); bar.st = (volatile LAS unsigned*)(lds + MISC_OFF) + 8;
    for (int ph = a0.ph_lo; ph < a0.ph_hi; ++ph) {
        Args a = a0; { size_t off = 0; asm volatile("" : "+s"(off)); a.ws = a0.ws + off; }
        unsigned char* ws = a.ws;
        if (ph == 0) phase_init(a, lds, vcu, NGW, wv);
        else {
            const int l = (ph - 1) / 5, sp = (ph - 1) % 5;
            if (sp == 1) phase_pool(a, l, vcu, NGW, wv);
            else if (sp == 2) phase_attn(a, l, lds, vcu, G, wv);
            for (int j = 0; j < 3; ++j) {
                pg8::Gemm g{nullptr, 0, nullptr, 0, MP, 0, 0, 0};
                EpiAll E{K_IN, ws, a.out, a.kn_gain + (size_t)l * 96, (l == 0) ? a.x : nullptr, a.meta, (l == DEPTH - 1) ? 1 : 0};
                const bf16_t* PROJ = (const bf16_t*)(ws + WS_PROJ); const unsigned char* wb = ws + WS_W;
                if (sp == 0 && j == 0)      { g.A = (const bf16_t*)(ws + WS_H); g.lda = 1024; g.Bt = (const bf16_t*)(wb + W_IN); g.ldb = 1024; g.N = NIN_PAD; g.K = 1024; E.kind = K_IN; }
                else if (sp == 1 && j == 0) { g.A = PROJ + C_CQ; g.lda = PW; g.Bt = (const bf16_t*)(wb + W_Q); g.ldb = 768; g.N = 768; g.K = 768; E.kind = K_Q; }
                else if (sp == 1 && j == 1) { g.A = PROJ + C_CKV; g.lda = PW; g.Bt = (const bf16_t*)(wb + W_KV); g.ldb = 256; g.N = 512; g.K = 256; E.kind = K_KV; }
                else if (sp == 1 && j == 2) { g.A = (const bf16_t*)(wb + W_KV) + 512 * 256; g.lda = 256; g.Bt = PROJ + C_CKV; g.ldb = PW; g.M = 512; g.N = MP; g.K = 256; E.kind = K_VT; }
                else if (sp == 2 && j == 0) { g.A = PROJ + C_P1Y; g.lda = PW; g.Bt = (const bf16_t*)(wb + W_PU); g.ldb = 512; g.N = 1024; g.K = 512; E.kind = K_POOLUP; }
                else if (sp == 3 && j == 0) { g.A = PROJ + C_OZ; g.lda = PW; g.Bt = (const bf16_t*)(wb + W_MU); g.ldb = 512; g.N = 1024; g.K = 512; E.kind = K_MLAUP; }
                else if (sp == 4 && j == 0) { g.A = (const bf16_t*)(ws + WS_QRAW)  ; g.lda = 1024; g.Bt = (const bf16_t*)(wb + W_O) + (size_t)(l & 1) * 1024 * 1024; g.ldb = 1024; g.N = 1024; g.K = 1024; E.kind = K_OUT; }
                else break;
                const int rot = (E.kind == K_KV) ? 134 : (E.kind == K_VT) ? 138 : 0;
                pg8::StaticOrder S; S.init(g.M, g.N, G, (bx + G - rot % G) % G); pg8::gemm_phase(lds, g, S, E, wv);
            }
            if ((sp == 4 && l + 1 < DEPTH) || (sp == 0 && l == 0)) {
                const int tid = opaque_tid(wv), lane = tid & 63, wave = __builtin_amdgcn_readfirstlane(tid >> 6);
                const bool nxt = (sp == 4);
                convert_weights(a, nxt ? l + 1 : 0, lds, (unsigned*)(ws + WS_CTL) + 8192 + 64 * (nxt ? l + 1 : 5), wave, lane, nxt ? 0 : CW_FIRST, CW_NITEMS);
            }
        }
        if (ph + 1 < a0.ph_hi) { if (ph == 0) { __syncthreads(); cg::this_grid().sync(); if (opaque_tid(wv) == 0) (void)xb_add(&bar.bar[XB_XCNT(bar.x)], 1u); } else xcd_barrier(bar, opaque_tid(wv)); }
    }
}

extern "C" void kernel_launch(void* const* d_in, const int* in_sizes, int n_in, void* d_out, int out_size, void* d_ws, size_t ws_size, hipStream_t stream) {
    static int grid = 0;
    if (grid == 0) {
        if (n_in != 16 || out_size != BATCH * SEQ * DM || ws_size < WS_END) { fprintf(stderr, "kernel_launch: unexpected shapes (n_in %d out %d ws %zu)\n", n_in, out_size, ws_size); grid = -1; return; }
        int dev = 0, cus = 0, per_cu = 0;
        hipGetDevice(&dev); hipDeviceGetAttribute(&cus, hipDeviceAttributeMultiprocessorCount, dev);
        if (hipFuncSetAttribute((const void*)trunk_fwd, hipFuncAttributeMaxDynamicSharedMemorySize, LDS_BYTES) != hipSuccess) { fprintf(stderr, "kernel_launch: hipFuncSetAttribute failed\n"); grid = -1; return; }
        if (hipOccupancyMaxActiveBlocksPerMultiprocessor(&per_cu, (const void*)trunk_fwd, 512, LDS_BYTES) != hipSuccess || per_cu < 1) { fprintf(stderr, "kernel_launch: occupancy query says %d\n", per_cu); per_cu = 1; }
        (void)hipGetLastError();
        grid = cus * 1;
    }
    if (grid < 0) return;
    Args a{};
    a.x = (const float*)d_in[0]; a.pos = (const int*)d_in[1]; a.meta = (const float*)d_in[2]; a.norm_gain = (const float*)d_in[3]; a.w_in = (const float*)d_in[4];
    a.pool_wg = (const float*)d_in[5]; a.pool_scale = (const float*)d_in[6]; a.pool_wu = (const float*)d_in[7]; a.qa_gain = (const float*)d_in[8]; a.kva_gain = (const float*)d_in[9];
    a.w_qb = (const float*)d_in[10]; a.w_kvb = (const float*)d_in[11]; a.qn_gain = (const float*)d_in[12]; a.kn_gain = (const float*)d_in[13]; a.mla_wu = (const float*)d_in[14]; a.w_out = (const float*)d_in[15];
    a.out = (float*)d_out; a.ws = (unsigned char*)d_ws;
#if MK_COOP
    a.ph_lo = 0; a.ph_hi = NPHASE;
    void* args[] = {&a};
    hipError_t e = hipLaunchCooperativeKernel((const void*)trunk_fwd, dim3(grid), dim3(512), args, LDS_BYTES, stream);
    if (e != hipSuccess) fprintf(stderr, "cooperative launch failed: %s (grid %d)\n", hipGetErrorString(e), grid);
#else
    for (int ph = 0; ph < NPHASE; ++ph) { a.ph_lo = ph; a.ph_hi = ph + 1; hipLaunchKernelGGL(trunk_fwd, dim3(grid), dim3(512), LDS_BYTES, stream, a); }
#endif
}
```

```cpp
#include <hip/hip_runtime.h>
#include <hip/hip_cooperative_groups.h>
#include <cstdio>
#include <cstdint>
namespace cg = cooperative_groups;

#ifndef MK_COOP
#define MK_COOP 1
#endif

#define LAS __attribute__((address_space(3)))
typedef unsigned short bf16_t;
typedef short bf16x8 __attribute__((ext_vector_type(8)));
typedef float f32x4 __attribute__((ext_vector_type(4)));
typedef float f32x16 __attribute__((ext_vector_type(16)));
typedef unsigned u32x4 __attribute__((ext_vector_type(4)));
typedef unsigned u32x2 __attribute__((ext_vector_type(2)));

constexpr int BATCH = 4, SEQ = 8192, DM = 1024, DEPTH = 4, NMETA = 16;
constexpr int PADF = 112, LP = 8320, MP = BATCH * LP;
constexpr int NH = 8;
constexpr int DIN = 4640;
constexpr float EPS = 1e-6f;
constexpr int PW = 4608;
constexpr int C_U = 0  , C_Z = 512, C_CQ = 1024, C_CKV = 1792, C_ZM = 2048, C_GP = 2560, C_GM = 3584;
constexpr int C_P1Y = 512  , C_MPOOL = 1024  , C_OZ = 0  ;
constexpr int NIN_PAD = 4864;

constexpr size_t MiB = 1u << 20;
constexpr size_t WS_CTL = 0, CTL_ZERO_BYTES = 65536;
constexpr size_t WS_W = 1 * MiB;
constexpr size_t W_IN = 0, W_Q = W_IN + (size_t)NIN_PAD * 1024 * 2, W_KV = W_Q + 768 * 768 * 2, W_G = W_KV + 1024 * 256 * 2,
                 W_PU = W_G + 512 * 256 * 2, W_MU = W_PU + 1024 * 512 * 2, W_O = W_MU + 1024 * 512 * 2  , W_END = W_O + 2 * 1024 * 1024 * 2;
static_assert(W_END <= 18 * MiB, "weights");
constexpr size_t WS_ROPE = 19 * MiB, WS_SSQH = 24 * MiB  , WS_SSQQ = 27 * MiB  , WS_SSQKV = 29 * MiB  ,
                 WS_METAH = 30 * MiB, WS_KROPE = 31 * MiB, WS_H = 34 * MiB  , WS_PROJ = 99 * MiB, WS_QRAW = 392 * MiB  , WS_V = 441 * MiB, WS_END = 474 * MiB;
static_assert(WS_H + (size_t)MP * 1024 * 2 <= WS_PROJ && WS_PROJ + (size_t)MP * PW * 2 <= WS_QRAW && WS_QRAW + (size_t)MP * 768 * 2 <= WS_V && WS_V + (size_t)MP * 512 * 2 <= WS_END && WS_QRAW + (size_t)MP * 1024 * 2 <= WS_END, "ws map");

constexpr int LDS_BYTES = 147456, MISC_OFF = 131072 + 320;

struct Args {
    const float* x; const int* pos; const float* meta; const float* norm_gain; const float* w_in; const float* pool_wg; const float* pool_scale; const float* pool_wu;
    const float* qa_gain; const float* kva_gain; const float* w_qb; const float* w_kvb; const float* qn_gain; const float* kn_gain; const float* mla_wu; const float* w_out;
    float* out; unsigned char* ws; int ph_lo, ph_hi;
};

__device__ __forceinline__ unsigned cvt_pk_bf16(float lo, float hi) { unsigned r; asm volatile("v_cvt_pk_bf16_f32 %0, %1, %2" : "=v"(r) : "v"(lo), "v"(hi)); return r; }
typedef float f32x2_t __attribute__((ext_vector_type(2))); typedef __bf16 bf16x2_t __attribute__((ext_vector_type(2)));
__device__ __forceinline__ unsigned cvtpk_s(float lo, float hi) { f32x2_t v = {lo, hi}; bf16x2_t b = __builtin_convertvector(v, bf16x2_t); return __builtin_bit_cast(unsigned, b); }
__device__ __forceinline__ float bf_lo(unsigned u) { return __uint_as_float(u << 16); }
__device__ __forceinline__ float bf_hi(unsigned u) { return __uint_as_float(u & 0xffff0000u); }
__device__ __forceinline__ float xor32f(float v) { const auto rr = __builtin_amdgcn_permlane32_swap(__float_as_uint(v), __float_as_uint(v), false, false); const unsigned me = __float_as_uint(v); return __uint_as_float(rr[0] == me ? rr[1] : rr[0]); }
__device__ __forceinline__ float xor16f(float v) { return __uint_as_float((unsigned)__builtin_amdgcn_ds_swizzle((int)__float_as_uint(v), 0x401F)); }
template <int M> __device__ __forceinline__ float xorswz(float v) { return __uint_as_float((unsigned)__builtin_amdgcn_ds_swizzle((int)__float_as_uint(v), (M << 10) | 0x1F)); }
__device__ __forceinline__ float wave_sum(float v) {
    v += xorswz<1>(v); v += xorswz<2>(v); v += xorswz<4>(v); v += xorswz<8>(v); v += xorswz<16>(v); v += xor32f(v);
    return v;
}
__device__ __forceinline__ float sigmoidf_(float g) { return __builtin_amdgcn_rcpf(1.f + __expf(-g)); }
__device__ __forceinline__ float siluf_(float z) { return z * sigmoidf_(z); }
#define LDS_WAIT() asm volatile("s_waitcnt lgkmcnt(0)" ::: "memory")
__device__ __forceinline__ u32x4 zero4() { unsigned z = 0u; asm volatile("" : "+v"(z)); return (u32x4){z, z, z, z}; }
__device__ __forceinline__ int opaque_tid(int wv) { int t = wv * 64 + (int)__builtin_amdgcn_mbcnt_hi(~0u, __builtin_amdgcn_mbcnt_lo(~0u, 0u)); asm volatile("" : "+v"(t)); return t; }

#define XB_TMO      128
#define XB_XCNT(j)  (256  + 64 * (j))
#define XB_XSUB(j)  (1280 + 64 * (j))
#define XB_XGEN(j)  (2304 + 64 * (j))
#define XB_TOP      3328
#define XB_TOPGEN   3392
#define XCD_BAR_WORDS 3456
#define XB_SPIN_CAP (1u << 18)

__device__ __forceinline__ unsigned xb_ld(unsigned* p)              { return __hip_atomic_load(p, __ATOMIC_RELAXED, __HIP_MEMORY_SCOPE_AGENT); }
__device__ __forceinline__ unsigned xb_add(unsigned* p, unsigned v) { return __hip_atomic_fetch_add(p, v, __ATOMIC_RELAXED, __HIP_MEMORY_SCOPE_AGENT); }
__device__ __forceinline__ unsigned xb_xcc_id() { return (unsigned)__builtin_amdgcn_s_getreg((3 << 11) | 20) & 0xFu; }
#define XB_SPIN(cond, bar) do { unsigned _sp = 0; while (cond) { __builtin_amdgcn_s_sleep(1); \
    if ((++_sp & 255u) == 0u) { if (xb_ld(&(bar)[XB_TMO])) break; if (_sp > XB_SPIN_CAP) { atomicAdd(&(bar)[XB_TMO], 1u); break; } } } } while (0)

struct XcdBarrier {
    unsigned* bar; unsigned x;
    volatile LAS unsigned* st;
};

__device__ __forceinline__ XcdBarrier xcd_barrier_post(unsigned* bar, volatile LAS unsigned* st, int tid) {
    XcdBarrier b; b.bar = bar; b.x = xb_xcc_id(); b.st = st;
    if (tid == 0) (void)xb_add(&bar[XB_XCNT(b.x)], 1u);
    return b;
}
__device__ __forceinline__ void xcd_barrier_complete(unsigned* bar, unsigned x, unsigned& nloc, unsigned& nx) {
    const unsigned G = gridDim.x * gridDim.y * gridDim.z;
    unsigned sum, cnt, mine, sp = 0u;
    for (;;) {
        sum = 0u; cnt = 0u; mine = 0u;
#pragma unroll
        for (unsigned j = 0; j < 16; ++j) { const unsigned c = xb_ld(&bar[XB_XCNT(j)]); sum += c; cnt += (c > 0u) ? 1u : 0u; mine = (j == x) ? c : mine; }
        if (sum == G) break;
        __builtin_amdgcn_s_sleep(1);
        if ((++sp & 255u) == 0u) { if (xb_ld(&bar[XB_TMO])) break; if (sp > XB_SPIN_CAP) { atomicAdd(&bar[XB_TMO], 1u); break; } }
    }
    nloc = mine > 0u ? mine : 1u; nx = cnt > 0u ? cnt : 1u;
}

__device__ __forceinline__ void xcd_barrier(const XcdBarrier& b, int tid) {
    asm volatile("s_waitcnt vmcnt(0)" ::: "memory");
    __syncthreads();
    if (tid == 0) {
        unsigned* bar = b.bar;
        __builtin_amdgcn_s_waitcnt(0);
        unsigned nloc = b.st[0], nx = b.st[1];
        if (nloc == 0u) { xcd_barrier_complete(bar, b.x, nloc, nx); b.st[0] = nloc; b.st[1] = nx; }
        const unsigned old = xb_add(&bar[XB_XSUB(b.x)], 1u);
        const unsigned gen = old / nloc;
        if (old + 1u == (gen + 1u) * nloc) {
            __builtin_amdgcn_fence(__ATOMIC_RELEASE, "agent");
            asm volatile("s_waitcnt vmcnt(0)" ::: "memory");
            const unsigned og = xb_add(&bar[XB_TOP], 1u);
            const unsigned tg = og / nx;
            if (og + 1u == (tg + 1u) * nx) xb_add(&bar[XB_TOPGEN], 1u);
            else XB_SPIN(xb_ld(&bar[XB_TOPGEN]) == tg, bar);
            __builtin_amdgcn_fence(__ATOMIC_ACQUIRE, "agent");
            xb_add(&bar[XB_XGEN(b.x)], 1u);
            asm volatile("s_waitcnt vmcnt(0)" ::: "memory");
        } else {
            XB_SPIN(xb_ld(&bar[XB_XGEN(b.x)]) == gen, bar);
            __builtin_amdgcn_fence(__ATOMIC_ACQUIRE, "agent");
            asm volatile("s_waitcnt vmcnt(0)" ::: "memory");
        }
    }
    __syncthreads();
}

namespace pg8 {
constexpr int BM = 256, BK = 64, HALF = 128, HTB = HALF * BK * 2, STAGE_BYTES = 8 * HTB, NXCD = 8, WGM = 8;
__host__ __device__ __forceinline__ int lds_byte(int r, int c) { const int st = (r >> 4) * 2 + (c >> 5), rr = r & 15, cc = c & 31, ob = rr * 64 + cc * 2; return st * 1024 + (ob ^ (((ob >> 9) & 1) << 5)); }
__host__ __device__ __forceinline__ void stage_rc(int b, int& R, int& C) { const int st = b / 1024, sb = b % 1024, swz = sb ^ (((sb >> 9) & 1) << 5); R = (st >> 1) * 16 + swz / 64; C = (st & 1) * 32 + (swz % 64) / 2; }
__host__ __device__ __forceinline__ int perm32(int rho) { const int n = rho >> 4, i = rho & 15; return 8 * (i >> 2) + 4 * n + (i & 3); }
struct Unit { int pm, pn; };
struct Gemm { const bf16_t* A; int lda; const bf16_t* Bt; int ldb; int M, N, K; int apn; };
struct StaticOrder {
    int nM, nN, nwg, G, c;
    __device__ void init(int M, int N, int G_, int c_) { nM = M / BM; nN = N / BM; nwg = nM * nN; G = G_; c = c_; }
    __device__ bool next(int i, Unit& u) const {
        const long L = (long)i * G + c; if (L >= nwg) return false;
        int wgid = (int)L; { const int q = nwg / NXCD, r = nwg % NXCD, xcd = wgid % NXCD, off = wgid / NXCD; wgid = (xcd < r ? xcd * (q + 1) : r * (q + 1) + (xcd - r) * q) + off; }
        const int nig = WGM * nN, gid = wgid / nig, fm = gid * WGM, gsz = (nM - fm) < WGM ? (nM - fm) : WGM;
        u.pm = fm + ((wgid % nig) % gsz); u.pn = (wgid % nig) / gsz; return true;
    }
};
template <class F> struct Epi {
    F f;
    __device__ __forceinline__ void operator()(const f32x4 (&acc)[2][2][4][2], const Unit& u, int wr, int wc, int fr, int fq) const {
        const int c0 = u.pn * BM + wc * 32 + 8 * fq;
#pragma unroll
        for (int ai = 0; ai < 2; ++ai)
#pragma unroll
            for (int mp = 0; mp < 4; mp += 2) {
                typename F::Ld ld[2];
#pragma unroll
                for (int m = 0; m < 2; ++m) f.load(ld[m], u.pm * BM + ai * HALF + wr * 64 + (mp + m) * 16 + fr, c0, u.pn, fq);
#pragma unroll
                for (int m = 0; m < 2; ++m) f.apply(ld[m], u.pm * BM + ai * HALF + wr * 64 + (mp + m) * 16 + fr, c0, u.pn, wc, fq, acc[ai][0][mp + m][0], acc[ai][0][mp + m][1], acc[ai][1][mp + m][0], acc[ai][1][mp + m][1]);
            }
    }
};

template <class EpiT>
__device__ __forceinline__ void gemm_phase(LAS unsigned char* lds, const Gemm g, const StaticOrder& S, const EpiT& E, int wv) {
    const int tid = opaque_tid(wv), wid = __builtin_amdgcn_readfirstlane(tid >> 6), lane = tid & 63, wr = wid >> 2, wc = wid & 3, fr = lane & 15, fq = lane >> 4;
    int K = g.K; asm volatile("" : "+s"(K)); const int nt = K / BK;
    unsigned voffA[2], voffB[2];
#pragma unroll
    for (int i = 0; i < 2; ++i) { int R, C; stage_rc(tid * 16 + i * 8192, R, C); const int Rb = (R & ~31) + perm32(R & 31);
        voffA[i] = (unsigned)(R * g.lda + C) * 2u; voffB[i] = (unsigned)(Rb * g.ldb + C) * 2u; }
    const size_t kstep = (size_t)(BK * 2);
    const size_t hA = (size_t)HALF * g.lda * 2, hB = (size_t)HALF * g.ldb * 2;
    const size_t tA = 2 * hA, tB = 2 * hB;
    const unsigned ldsw = (unsigned)wid * 1024u;
    const int aoff = lds_byte(wr * 64 + fr, fq * 8), boff = lds_byte(wc * 32 + fr, fq * 8);
#define PG8_SA(b, h) (((b) * 2 + (h)) * HTB)
#define PG8_SB(b, h) ((4 + (b) * 2 + (h)) * HTB)
#define PG8_STAGE(bufoff, gbase, voff) do { _Pragma("unroll") for (int _i = 0; _i < 2; ++_i) \
        __builtin_amdgcn_global_load_lds((const unsigned*)((const char*)(gbase) + (voff)[_i]), (LAS unsigned*)(lds + (bufoff) + ldsw + _i * 8192), 16, 0, 0); } while (0)
#define PG8_LDA(dst, b, h) do { _Pragma("unroll") for (int m = 0; m < 4; ++m) _Pragma("unroll") for (int k = 0; k < 2; ++k) dst[m][k] = *(const LAS bf16x8*)(lds + PG8_SA(b, h) + aoff + m * 2048 + k * 1024); } while (0)
#define PG8_LDB(dst, b, h) do { _Pragma("unroll") for (int n = 0; n < 2; ++n) _Pragma("unroll") for (int k = 0; k < 2; ++k) dst[n][k] = *(const LAS bf16x8*)(lds + PG8_SB(b, h) + boff + n * 2048 + k * 1024); } while (0)
#define PG8_MMA(ai, bj, At, Bt) do { __builtin_amdgcn_s_setprio(1); _Pragma("unroll") for (int m = 0; m < 4; ++m) _Pragma("unroll") for (int n = 0; n < 2; ++n) _Pragma("unroll") for (int k = 0; k < 2; ++k) \
        acc[ai][bj][m][n] = __builtin_amdgcn_mfma_f32_16x16x32_bf16(Bt[n][k], At[m][k], acc[ai][bj][m][n], 0, 0, 0); __builtin_amdgcn_s_setprio(0); } while (0)
#define PG8_WAIT_V(n) asm volatile("s_waitcnt vmcnt(" #n ")" ::: "memory")
#define PG8_WAIT_L(n) asm volatile("s_waitcnt lgkmcnt(" #n ")" ::: "memory")
#define PG8_BAR __builtin_amdgcn_s_barrier()
#define PG8_SCHED __builtin_amdgcn_sched_barrier(0)
    Unit cur, nxt; int ui = 0;
    if (!S.next(0, cur)) return;
    f32x4 acc[2][2][4][2];
    { float z = 0.f; asm volatile("" : "+v"(z));
#pragma unroll
    for (int a = 0; a < 2; ++a)
#pragma unroll
        for (int b = 0; b < 2; ++b)
#pragma unroll
            for (int m = 0; m < 4; ++m)
#pragma unroll
                for (int n = 0; n < 2; ++n) acc[a][b][m][n] = (f32x4){z, z, z, z}; }
    bf16x8 At[4][2], B0[2][2], B1[2][2];
    const char* cA = (const char*)g.A + (size_t)cur.pm * tA + (size_t)cur.pn * g.apn * 2; const char* cB = (const char*)g.Bt + (size_t)cur.pn * tB;
    PG8_STAGE(PG8_SB(0, 0), cB, voffB); PG8_STAGE(PG8_SB(0, 1), cB + hB, voffB); PG8_STAGE(PG8_SA(0, 0), cA, voffA); PG8_STAGE(PG8_SA(0, 1), cA + hA, voffA);
    if (wr == 1) PG8_BAR;
    PG8_WAIT_V(2); PG8_BAR;
    PG8_STAGE(PG8_SB(1, 0), cB + kstep, voffB); PG8_STAGE(PG8_SA(1, 0), cA + kstep, voffA); PG8_STAGE(PG8_SB(1, 1), cB + hB + kstep, voffB);
    PG8_WAIT_V(6); PG8_BAR;
    for (;;) {
        const bool has_next = S.next(ui + 1, nxt);
        const char* nA = has_next ? (const char*)g.A + (size_t)nxt.pm * tA + (size_t)nxt.pn * g.apn * 2 : cA; const char* nB = has_next ? (const char*)g.Bt + (size_t)nxt.pn * tB : cB;
#pragma unroll 1
        for (int t = 0; t < nt; t += 2) {
            const bool last = (t == nt - 2);
            const char* a1 = cA + (size_t)(t + 1) * kstep;
            const char* a2 = last ? nA : cA + (size_t)(t + 2) * kstep; const char* b2 = last ? nB : cB + (size_t)(t + 2) * kstep;
            const char* a3 = a2 + kstep; const char* b3 = b2 + kstep;
            PG8_LDB(B0, 0, 0); PG8_LDB(B1, 0, 1); PG8_SCHED; PG8_LDA(At, 0, 0); PG8_STAGE(PG8_SA(1, 1), a1 + hA, voffA);
            PG8_WAIT_V(8); PG8_WAIT_L(0); PG8_BAR; PG8_MMA(0, 0, At, B0); PG8_MMA(0, 1, At, B1); PG8_BAR; PG8_SCHED;
            PG8_LDA(At, 0, 1); PG8_STAGE(PG8_SB(0, 0), b2, voffB); PG8_STAGE(PG8_SB(0, 1), b2 + hB, voffB); PG8_STAGE(PG8_SA(0, 0), a2, voffA);
            PG8_WAIT_V(8); PG8_WAIT_L(0); PG8_BAR; PG8_MMA(1, 0, At, B0); PG8_MMA(1, 1, At, B1); PG8_BAR; PG8_SCHED;
            PG8_LDB(B0, 1, 0); PG8_LDB(B1, 1, 1); PG8_SCHED; PG8_LDA(At, 1, 0); PG8_STAGE(PG8_SA(0, 1), a2 + hA, voffA);
            PG8_WAIT_V(8); PG8_WAIT_L(0); PG8_BAR; PG8_MMA(0, 0, At, B0); PG8_MMA(0, 1, At, B1); PG8_BAR; PG8_SCHED;
            PG8_LDA(At, 1, 1); PG8_STAGE(PG8_SB(1, 0), b3, voffB); PG8_STAGE(PG8_SB(1, 1), b3 + hB, voffB); PG8_STAGE(PG8_SA(1, 0), a3, voffA);
            PG8_WAIT_V(8); PG8_WAIT_L(0); PG8_BAR; PG8_MMA(1, 0, At, B0); PG8_MMA(1, 1, At, B1); PG8_BAR; PG8_SCHED;
        }
        if (wr == 0) PG8_BAR;
        E(acc, cur, wr, wc, fr, fq);
        if (!has_next) break;
        { float z = 0.f; asm volatile("" : "+v"(z));
#pragma unroll
        for (int a = 0; a < 2; ++a)
#pragma unroll
            for (int b = 0; b < 2; ++b)
#pragma unroll
                for (int m = 0; m < 4; ++m)
#pragma unroll
                    for (int n = 0; n < 2; ++n) acc[a][b][m][n] = (f32x4){z, z, z, z}; }
        cur = nxt; cA = nA; cB = nB; ++ui;
        if (wr == 1) PG8_BAR;
    }
    PG8_WAIT_V(0);
    PG8_BAR;
#undef PG8_SA
#undef PG8_SB
#undef PG8_STAGE
#undef PG8_LDA
#undef PG8_LDB
#undef PG8_MMA
#undef PG8_WAIT_V
#undef PG8_WAIT_L
#undef PG8_BAR
#undef PG8_SCHED
}
}

__device__ __forceinline__ u32x4 pack8(const f32x4& a, const f32x4& b) { u32x4 w; w.x = cvt_pk_bf16(a[0], a[1]); w.y = cvt_pk_bf16(a[2], a[3]); w.z = cvt_pk_bf16(b[0], b[1]); w.w = cvt_pk_bf16(b[2], b[3]); return w; }
__device__ __forceinline__ void unpack8(const u32x4& w, float (&v)[8]) { v[0] = bf_lo(w.x); v[1] = bf_hi(w.x); v[2] = bf_lo(w.y); v[3] = bf_hi(w.y); v[4] = bf_lo(w.z); v[5] = bf_hi(w.z); v[6] = bf_lo(w.w); v[7] = bf_hi(w.w); }

__device__ __forceinline__ float row_inv16(const float* p16, float invn) {
    const f32x4 a = ((const f32x4*)p16)[0], b = ((const f32x4*)p16)[1], c = ((const f32x4*)p16)[2], d = ((const f32x4*)p16)[3];
    const float s = ((a[0] + a[1]) + (a[2] + a[3])) + ((b[0] + b[1]) + (b[2] + b[3])) + ((c[0] + c[1]) + (c[2] + c[3])) + ((d[0] + d[1]) + (d[2] + d[3]));
    return 1.0f / sqrtf(s * invn + EPS);
}
struct FIn {
    bf16_t* proj; bf16_t* krope; const float* ssqh; float* ssqq; float* ssqkv;
    struct Ld { f32x4 p[4]; };
    __device__ __forceinline__ void load(Ld& d, int row, int, int, int) const {
#pragma unroll
        for (int i = 0; i < 4; ++i) d.p[i] = ((const f32x4*)(ssqh + (size_t)row * 16))[i]; }
    __device__ __forceinline__ void apply(const Ld& d, int row, int c0, int pn, int wc, int fq, const f32x4& a0, const f32x4& b0, const f32x4& a1, const f32x4& b1) const {
        const f32x4 t = (d.p[0] + d.p[1]) + (d.p[2] + d.p[3]);
        const float inv = __builtin_amdgcn_rsqf(((t[0] + t[1]) + (t[2] + t[3])) * (1.f / DM) + EPS);
        const f32x4 v0 = a0 * inv, v1 = b0 * inv, v2 = a1 * inv, v3 = b1 * inv;
        if (pn < 18) { *(u32x4*)(proj + (size_t)row * PW + c0) = pack8(v0, v1); *(u32x4*)(proj + (size_t)row * PW + c0 + 128) = pack8(v2, v3); }
        else if (c0 < 4608 + 32) *(u32x4*)(krope + (size_t)row * 32 + (c0 - 4608)) = pack8(v0, v1);
        if (pn >= 4 && pn < 8) {
            const f32x4 sq = v0 * v0 + v1 * v1 + v2 * v2 + v3 * v3; float ss = (sq[0] + sq[1]) + (sq[2] + sq[3]);
            ss += xor16f(ss); ss += xor32f(ss);
            if (fq == 0) { if (pn < 7) ssqq[(size_t)row * 12 + (pn - 4) * 4 + wc] = ss; else ssqkv[(size_t)row * 4 + wc] = ss; }
        }
    }
};
struct FQ {
    bf16_t* o; const float* ssqq;
    struct Ld { f32x4 p[3]; };
    __device__ __forceinline__ void load(Ld& d, int row, int, int, int) const {
#pragma unroll
        for (int i = 0; i < 3; ++i) d.p[i] = ((const f32x4*)(ssqq + (size_t)row * 12))[i]; }
    __device__ __forceinline__ void apply(const Ld& d, int row, int c0, int, int, int, const f32x4& a0, const f32x4& b0, const f32x4& a1, const f32x4& b1) const {
        const f32x4 t = d.p[0] + d.p[1] + d.p[2];
        const float inv = __builtin_amdgcn_rsqf(((t[0] + t[1]) + (t[2] + t[3])) * (1.f / 768.f) + EPS);
        *(u32x4*)(o + (size_t)row * 768 + c0) = pack8(a0 * inv, b0 * inv); *(u32x4*)(o + (size_t)row * 768 + c0 + 128) = pack8(a1 * inv, b1 * inv); }
};
struct FKV {
    bf16_t* Kb; const bf16_t* krope; const float* rope; const float* ssqkv; const float* gk;
    struct Ld { f32x4 pp, cs, sn; u32x2 r1, r2; };
    __device__ __forceinline__ void load(Ld& d, int row, int, int, int fq) const {
        d.pp = *(const f32x4*)(ssqkv + (size_t)row * 4);
        d.r1 = *(const u32x2*)(krope + (size_t)row * 32 + 4 * fq); d.r2 = *(const u32x2*)(krope + (size_t)row * 32 + 16 + 4 * fq);
        d.cs = *(const f32x4*)(rope + (size_t)row * 32 + 4 * fq); d.sn = *(const f32x4*)(rope + (size_t)row * 32 + 16 + 4 * fq); }
    __device__ __forceinline__ void apply(const Ld& d, int row, int, int pn, int wc, int fq, const f32x4& a0, const f32x4& b0, const f32x4& a1, const f32x4& b1) const {
        const float akv = __builtin_amdgcn_rsqf(((d.pp[0] + d.pp[1]) + (d.pp[2] + d.pp[3])) * (1.f / 256.f) + EPS);
        const f32x4 v0 = a0 * akv, v1 = b0 * akv, v2 = a1 * akv, v3 = b1 * akv;
        const int h = 4 * pn + wc, b = row / LP, p = row - b * LP;
        const f32x4 x1 = (f32x4){bf_lo(d.r1.x), bf_hi(d.r1.x), bf_lo(d.r1.y), bf_hi(d.r1.y)}, x2 = (f32x4){bf_lo(d.r2.x), bf_hi(d.r2.x), bf_lo(d.r2.y), bf_hi(d.r2.y)};
        const f32x4 sq = v0 * v0 + v1 * v1 + v2 * v2 + v3 * v3 + x1 * x1 + x2 * x2;
        float ss = (sq[0] + sq[1]) + (sq[2] + sq[3]);
        ss += xor16f(ss); ss += xor32f(ss);
        const float inv = __builtin_amdgcn_rsqf(ss * (1.f / 96.f) + EPS);
        const f32x4 g0 = *(const f32x4*)(gk + 8 * fq), g1 = *(const f32x4*)(gk + 8 * fq + 4), g2 = *(const f32x4*)(gk + 32 + 8 * fq), g3 = *(const f32x4*)(gk + 32 + 8 * fq + 4);
        const f32x4 gr1 = *(const f32x4*)(gk + 64 + 4 * fq), gr2 = *(const f32x4*)(gk + 80 + 4 * fq);
        bf16_t* dst = Kb + ((size_t)(b * NH + h) * LP + p) * 96;
        *(u32x4*)(dst + 8 * fq) = pack8(v0 * inv * g0, v1 * inv * g1);
        *(u32x4*)(dst + 32 + 8 * fq) = pack8(v2 * inv * g2, v3 * inv * g3);
        const f32x4 y1 = x1 * inv * gr1, y2 = x2 * inv * gr2;
        const f32x4 o1 = y1 * d.cs - y2 * d.sn, o2 = y2 * d.cs + y1 * d.sn;
        u32x2 w1, w2; w1.x = cvt_pk_bf16(o1[0], o1[1]); w1.y = cvt_pk_bf16(o1[2], o1[3]); w2.x = cvt_pk_bf16(o2[0], o2[1]); w2.y = cvt_pk_bf16(o2[2], o2[3]);
        *(u32x2*)(dst + 64 + 4 * fq) = w1; *(u32x2*)(dst + 80 + 4 * fq) = w2;
    }
};
struct FPoolUp {
    bf16_t* proj;
    struct Ld { u32x4 g0, g1; };
    __device__ __forceinline__ void load(Ld& d, int row, int c0, int, int) const { d.g0 = *(const u32x4*)(proj + (size_t)row * PW + C_GP + c0); d.g1 = *(const u32x4*)(proj + (size_t)row * PW + C_GP + c0 + 128); }
    __device__ __forceinline__ void half(const u32x4& gw, int row, int col, const f32x4& a, const f32x4& b) const {
        float g[8]; unpack8(gw, g);
        f32x4 r0, r1;
#pragma unroll
        for (int i = 0; i < 4; ++i) { r0[i] = a[i] * sigmoidf_(g[i]); r1[i] = b[i] * sigmoidf_(g[4 + i]); }
        *(u32x4*)(proj + (size_t)row * PW + C_MPOOL + col) = pack8(r0, r1);
    }
    __device__ __forceinline__ void apply(const Ld& d, int row, int c0, int, int, int, const f32x4& a0, const f32x4& b0, const f32x4& a1, const f32x4& b1) const { half(d.g0, row, c0, a0, b0); half(d.g1, row, c0 + 128, a1, b1); }
};
struct FMlaUp {
    const bf16_t* proj; bf16_t* merged;
    struct Ld { u32x4 g0, g1, p0, p1; };
    __device__ __forceinline__ void load(Ld& d, int row, int c0, int, int) const {
        d.g0 = *(const u32x4*)(proj + (size_t)row * PW + C_GM + c0); d.g1 = *(const u32x4*)(proj + (size_t)row * PW + C_GM + c0 + 128);
        d.p0 = *(const u32x4*)(proj + (size_t)row * PW + C_MPOOL + c0); d.p1 = *(const u32x4*)(proj + (size_t)row * PW + C_MPOOL + c0 + 128); }
    __device__ __forceinline__ void half(const u32x4& gw, const u32x4& pw, int row, int col, const f32x4& a, const f32x4& b) const {
        float g[8]; unpack8(gw, g); float p[8]; unpack8(pw, p);
        f32x4 r0, r1;
#pragma unroll
        for (int i = 0; i < 4; ++i) { r0[i] = a[i] * sigmoidf_(g[i]) + p[i]; r1[i] = b[i] * sigmoidf_(g[4 + i]) + p[4 + i]; }
        *(u32x4*)(merged + (size_t)row * 1024 + col) = pack8(r0, r1);
    }
    __device__ __forceinline__ void apply(const Ld& d, int row, int c0, int, int, int, const f32x4& a0, const f32x4& b0, const f32x4& a1, const f32x4& b1) const { half(d.g0, d.p0, row, c0, a0, b0); half(d.g1, d.p1, row, c0 + 128, a1, b1); }
};
__device__ __forceinline__ float* hres_row(float* out, float* metah, int row) {
    const int b = row / LP, t = row - b * LP - PADF;
    if (t < 0) return nullptr;
    if (t < NMETA) return metah + (size_t)(b * NMETA + t) * DM;
    return out + ((size_t)b * SEQ + (t - NMETA)) * DM;
}
struct FOut {
    float* out; float* metah; bf16_t* hb; float* ssqh; const float* xin; const float* metain;
    struct Ld { f32x4 v[4]; };
    __device__ __forceinline__ void load(Ld& d, int row, int c0, int, int) const {
        const int b = row / LP, t = row - b * LP - PADF;
        const f32x4 z = (f32x4){0.f, 0.f, 0.f, 0.f}; d.v[0] = z; d.v[1] = z; d.v[2] = z; d.v[3] = z;
        if (t >= 0) { const float* sr = xin ? ((t < NMETA) ? metain + (size_t)t * DM : xin + ((size_t)b * SEQ + (t - NMETA)) * DM) : hres_row(out, metah, row);
            d.v[0] = *(const f32x4*)(sr + c0); d.v[1] = *(const f32x4*)(sr + c0 + 4); d.v[2] = *(const f32x4*)(sr + c0 + 128); d.v[3] = *(const f32x4*)(sr + c0 + 132); }
    }
    __device__ __forceinline__ void apply(const Ld& d, int row, int c0, int pn, int wc, int fq, const f32x4& a0, const f32x4& b0, const f32x4& a1, const f32x4& b1) const {
        float* r = hres_row(out, metah, row);
        f32x4 v0 = (f32x4){0.f, 0.f, 0.f, 0.f}, v1 = v0, v2 = v0, v3 = v0;
        if (r) { v0 = d.v[0] + a0; v1 = d.v[1] + b0; v2 = d.v[2] + a1; v3 = d.v[3] + b1;
            *(f32x4*)(r + c0) = v0; *(f32x4*)(r + c0 + 4) = v1; *(f32x4*)(r + c0 + 128) = v2; *(f32x4*)(r + c0 + 132) = v3; }
        if (!hb) return;
        *(u32x4*)(hb + (size_t)row * DM + c0) = pack8(v0, v1); *(u32x4*)(hb + (size_t)row * DM + c0 + 128) = pack8(v2, v3);
        const f32x4 sq = v0 * v0 + v1 * v1 + v2 * v2 + v3 * v3;
        float ss = (sq[0] + sq[1]) + (sq[2] + sq[3]);
        ss += xor16f(ss); ss += xor32f(ss);
        if (fq == 0) ssqh[(size_t)row * 16 + 4 * pn + wc] = ss;
    }
};
enum { K_IN = 0, K_Q = 1, K_KV = 2, K_POOLUP = 3, K_MLAUP = 4, K_OUT = 5, K_VT = 6 };
struct EpiAll {
    int kind; unsigned char* ws; float* out; const float* gk; const float* xin; const float* metain; int last;
    __device__ __forceinline__ void operator()(const f32x4 (&acc)[2][2][4][2], const pg8::Unit& u, int wr, int wc, int fr, int fq) const {
        bf16_t* proj = (bf16_t*)(ws + WS_PROJ);
        switch (kind) {
            case K_IN:     { pg8::Epi<FIn> e{{proj, (bf16_t*)(ws + WS_KROPE), (const float*)(ws + WS_SSQH), (float*)(ws + WS_SSQQ), (float*)(ws + WS_SSQKV)}}; e(acc, u, wr, wc, fr, fq); } break;
            case K_Q:      { pg8::Epi<FQ> e{{(bf16_t*)(ws + WS_QRAW), (const float*)(ws + WS_SSQQ)}}; e(acc, u, wr, wc, fr, fq); } break;
            case K_KV:     { pg8::Epi<FKV> e{{(bf16_t*)(ws + WS_H), (const bf16_t*)(ws + WS_KROPE), (const float*)(ws + WS_ROPE), (const float*)(ws + WS_SSQKV), gk}}; e(acc, u, wr, wc, fr, fq); } break;
            case K_VT: {
                bf16_t* vt = (bf16_t*)(ws + WS_V); const float* ssqkv = (const float*)(ws + WS_SSQKV);
                const int c0 = u.pn * pg8::BM + wc * 32 + 8 * fq; float sc[2][8];
#pragma unroll
                for (int hf = 0; hf < 2; ++hf)
#pragma unroll
                    for (int i = 0; i < 8; ++i) { const f32x4 pp = *(const f32x4*)(ssqkv + (size_t)(c0 + 128 * hf + i) * 4); sc[hf][i] = __builtin_amdgcn_rsqf(((pp[0] + pp[1]) + (pp[2] + pp[3])) * (1.f / 256.f) + EPS); }
#pragma unroll
                for (int ai = 0; ai < 2; ++ai)
#pragma unroll
                    for (int m = 0; m < 4; ++m) { bf16_t* d = vt + (size_t)(u.pm * pg8::BM + ai * pg8::HALF + wr * 64 + m * 16 + fr) * MP + c0;
#pragma unroll
                        for (int hf = 0; hf < 2; ++hf) { f32x4 x = acc[ai][hf][m][0], y = acc[ai][hf][m][1];
#pragma unroll
                            for (int i = 0; i < 4; ++i) { x[i] *= sc[hf][i]; y[i] *= sc[hf][4 + i]; }
                            *(u32x4*)(d + 128 * hf) = pack8(x, y); }
                        asm volatile("" ::: "memory"); }
            } break;
            case K_POOLUP: { pg8::Epi<FPoolUp> e{{proj}}; e(acc, u, wr, wc, fr, fq); } break;
            case K_MLAUP:  { pg8::Epi<FMlaUp> e{{proj, (bf16_t*)(ws + WS_QRAW)}}; e(acc, u, wr, wc, fr, fq); } break;
            default:       { pg8::Epi<FOut> e{{out, (float*)(ws + WS_METAH), last ? nullptr : (bf16_t*)(ws + WS_H), (float*)(ws + WS_SSQH), xin, metain}}; e(acc, u, wr, wc, fr, fq); } break;
        }
    }
};

__device__ __forceinline__ void tr_item(const float* W, int ldw, int k0, int n0, bf16_t* WT, int ldt, int drow0, int dk0, LAS float* scr, int lane, const float* kgain = nullptr) {
#pragma unroll 8
    for (int i = 0; i < 32; ++i) { const int kk = 2 * i + (lane >> 5); float w = W[(size_t)(k0 + kk) * ldw + n0 + (lane & 31)]; if (kgain) w *= kgain[k0 + kk]; scr[kk * 33 + (lane & 31)] = w; }
    LDS_WAIT(); asm volatile("" ::: "memory");
    const int c = lane & 7;
#pragma unroll
    for (int j = 0; j < 4; ++j) { const int n = (lane >> 3) + 8 * j; const LAS float* s = scr + (8 * c) * 33 + n;
        u32x4 o; o.x = cvt_pk_bf16(s[0 * 33], s[1 * 33]); o.y = cvt_pk_bf16(s[2 * 33], s[3 * 33]); o.z = cvt_pk_bf16(s[4 * 33], s[5 * 33]); o.w = cvt_pk_bf16(s[6 * 33], s[7 * 33]);
        *(u32x4*)(WT + (size_t)(drow0 + n) * ldt + dk0 + 8 * c) = o; }
    LDS_WAIT(); asm volatile("" ::: "memory");
}
__device__ __forceinline__ void wcomb_item(const float* w_in, const float* wg, const float* ngain, bf16_t* WinT, int item, int lane) {
    const int g = item >> 8, kb = (item >> 2) & 63, db = item & 3, kk = lane >> 2, dq = lane & 3, k = kb * 16 + kk, d0 = db * 32 + 8 * dq;
    const float* ap = w_in + (size_t)k * DIN + 128 * g; const float* bp = wg + (size_t)g * 128 * 128 + d0;
    f32x4 c0 = (f32x4){0.f, 0.f, 0.f, 0.f}, c1 = c0;
#pragma unroll 4
    for (int cin = 0; cin < 128; ++cin) { const float av = ap[cin]; const f32x4 b0 = *(const f32x4*)(bp + (size_t)cin * 128), b1 = *(const f32x4*)(bp + (size_t)cin * 128 + 4); c0 += b0 * av; c1 += b1 * av; }
    const float gn = ngain[k];
    bf16_t* o = WinT + (size_t)(128 * g + d0) * 1024 + k;
#pragma unroll
    for (int i = 0; i < 4; ++i) { o[(size_t)i * 1024] = (bf16_t)(cvt_pk_bf16(c0[i] * gn, 0.f) & 0xffffu); o[(size_t)(4 + i) * 1024] = (bf16_t)(cvt_pk_bf16(c1[i] * gn, 0.f) & 0xffffu); }
}
constexpr int CW_I_C = 1024, CW_I_IN = 16 * 129, CW_I_Z = 28, CW_FIRST = CW_I_C + CW_I_IN + CW_I_Z;
__device__ __forceinline__ void convert_weights(const Args& a, int l, LAS unsigned char* lds, unsigned* ctr, int wave, int lane, int lo, int hi, int sgw = 0, int sngw = 1) {
    LAS float* scr = (LAS float*)(lds + wave * 16384);
    unsigned char* wb = a.ws + WS_W;
    bf16_t* WinT = (bf16_t*)(wb + W_IN); bf16_t* WqT = (bf16_t*)(wb + W_Q); bf16_t* WkvT = (bf16_t*)(wb + W_KV);
    bf16_t* WpuT = (bf16_t*)(wb + W_PU); bf16_t* WmuT = (bf16_t*)(wb + W_MU); bf16_t* WoT = (bf16_t*)(wb + W_O + (size_t)(l & 1) * 1024 * 1024 * 2);
    const float* w_in = a.w_in + (size_t)l * 1024 * DIN; const float* w_g = a.pool_wg + (size_t)l * 4 * 128 * 128; const float* w_pu = a.pool_wu + (size_t)l * 512 * 1024;
    const float* w_qb = a.w_qb + (size_t)l * 768 * 768; const float* w_kvb = a.w_kvb + (size_t)l * 256 * 1024; const float* w_mu = a.mla_wu + (size_t)l * 512 * 1024; const float* w_o = a.w_out + (size_t)l * 1024 * 1024;
    const float* ngain = a.norm_gain + (size_t)l * DM;
    constexpr int I_C = 1024, I_IN = 16 * 129, I_Q = 12 * 24, I_KV = 4 * 32, I_PU = 8 * 32, I_MU = 8 * 32, I_O = 16 * 32;
    constexpr int I_Z = 28; static_assert(I_C == CW_I_C && I_IN == CW_I_IN && I_Z == CW_I_Z, "item map");
    int sidx = sgw;
    for (;;) {
        int it = 0;
        if (ctr) { if (lane == 0) it = (int)__hip_atomic_fetch_add(ctr, 1u, __ATOMIC_RELAXED, __HIP_MEMORY_SCOPE_AGENT); it = __builtin_amdgcn_readfirstlane(it); }
        else { it = sidx; sidx += sngw; }
        it += lo;
        if (it >= hi) break;
        int r = it;
        if (r < I_C) { wcomb_item(w_in, w_g, ngain, WinT, r, lane); continue; } r -= I_C;
        if (r < I_IN) { const int kb = r / 129, nb = r % 129 + 16, n0 = nb * 32; const int d = (n0 < 2048) ? n0 : (n0 < 2080 ? 4608 : n0 - 32);
            tr_item(w_in, DIN, kb * 64, n0, WinT, 1024, d, kb * 64, scr, lane, ngain); continue; } r -= I_IN;
        if (r < I_Z) { u32x4* z = (u32x4*)(WinT + (size_t)4640 * 1024) + (size_t)r * 1024 + lane; const u32x4 zz = zero4();
#pragma unroll
            for (int i = 0; i < 16; ++i) z[64 * i] = zz;
            continue; } r -= I_Z;
        if (r < I_Q) { const int kb = r / 24, nb = r % 24; tr_item(w_qb, 768, kb * 64, nb * 32, WqT, 768, nb * 32, kb * 64, scr, lane, a.qa_gain + (size_t)l * 768); continue; } r -= I_Q;
        if (r < I_KV) { const int kb = r / 32, nb = r % 32, h = nb >> 2, q = nb & 3;
            const int d = (q < 2) ? 256 * (h >> 2) + 128 * q + 32 * (h & 3) : 512 + h * 64 + 32 * (q - 2);
            tr_item(w_kvb, 1024, kb * 64, nb * 32, WkvT, 256, d, kb * 64, scr, lane, a.kva_gain + (size_t)l * 256); continue; } r -= I_KV;
        if (r < I_PU) { const int kb = r / 32, nb = r % 32; tr_item(w_pu, 1024, kb * 64, nb * 32, WpuT, 512, nb * 32, kb * 64, scr, lane); continue; } r -= I_PU;
        if (r < I_MU) { const int kb = r / 32, nb = r % 32; tr_item(w_mu, 1024, kb * 64, nb * 32, WmuT, 512, nb * 32, kb * 64, scr, lane); continue; } r -= I_MU;
        { const int kb = r / 32, nb = r % 32; tr_item(w_o, 1024, kb * 64, nb * 32, WoT, 1024, nb * 32, kb * 64, scr, lane); }
    }
}

constexpr int CW_NITEMS = CW_FIRST + 12 * 24 + 4 * 32 + 8 * 32 + 8 * 32 + 16 * 32;
__device__ __forceinline__ void row_to_hb(const float* src, bf16_t* dst, float* ssq16, int lane) {
    unsigned long long* o8 = (unsigned long long*)dst + lane;
    float s = 0.f;
    if (!src) {
#pragma unroll
        for (int j = 0; j < 4; ++j) o8[64 * j] = 0ull;
    } else {
        const f32x4* xr = (const f32x4*)src + lane;
#pragma unroll
        for (int j = 0; j < 4; ++j) { const f32x4 v = xr[64 * j]; s += (v.x * v.x + v.y * v.y) + (v.z * v.z + v.w * v.w);
            o8[64 * j] = (unsigned long long)cvt_pk_bf16(v.x, v.y) | ((unsigned long long)cvt_pk_bf16(v.z, v.w) << 32); }
        s = wave_sum(s);
    }
    if (lane < 16) ssq16[lane] = (lane == 0) ? s : 0.f;
}

__constant__ double c_inv_freq[16] = {1.0, 0.5623413251903491, 0.31622776601683794, 0.1778279410038923, 0.1, 0.05623413251903491, 0.03162277660168379, 0.01778279410038923,
                                       0.01, 0.005623413251903491, 0.0031622776601683794, 0.0017782794100389228, 0.001, 0.0005623413251903491, 0.00031622776601683794, 0.00017782794100389227};
__device__ __forceinline__ void sincos_d(double ang, float& c, float& s) {
    const double k = rint(ang * 0.6366197723675814); const double y = fma(-k, 6.123233995736766e-17, fma(-k, 1.5707963267948966, ang));
    const double y2 = y * y;
    const double sn = y * (1.0 - y2 / 6.0 * (1.0 - y2 / 20.0 * (1.0 - y2 / 42.0 * (1.0 - y2 / 72.0 * (1.0 - y2 / 110.0 * (1.0 - y2 / 156.0))))));
    const double cs = 1.0 - y2 / 2.0 * (1.0 - y2 / 12.0 * (1.0 - y2 / 30.0 * (1.0 - y2 / 56.0 * (1.0 - y2 / 90.0 * (1.0 - y2 / 132.0 * (1.0 - y2 / 182.0))))));
    const int q = ((int)(long long)k) & 3;
    const double cc = (q == 0) ? cs : (q == 1) ? -sn : (q == 2) ? -cs : sn;
    const double ss = (q == 0) ? sn : (q == 1) ? cs : (q == 2) ? -sn : -cs;
    c = (float)cc; s = (float)ss;
}

__device__ __forceinline__ void phase_init(const Args& a, LAS unsigned char* lds, int vcu, int NGW, int wv) {
    const int tid = opaque_tid(wv), lane = tid & 63, wave = __builtin_amdgcn_readfirstlane(tid >> 6), gw = vcu * 8 + wave;
    bf16_t* H = (bf16_t*)(a.ws + WS_H); float* metah = (float*)(a.ws + WS_METAH); float* rope = (float*)(a.ws + WS_ROPE);
    for (int m0 = gw; m0 < MP; m0 += 2 * NGW) {
        f32x4 v[2][4]; const float* srcs[2];
#pragma unroll
        for (int k = 0; k < 2; ++k) { const int m = m0 + k * NGW; srcs[k] = nullptr;
            if (m < MP) { const int b = m / LP, t = m - b * LP - PADF;
                srcs[k] = (t < 0) ? nullptr : (t < NMETA ? a.meta + (size_t)t * DM : a.x + ((size_t)b * SEQ + (t - NMETA)) * DM); }
            if (srcs[k]) {
#pragma unroll
                for (int j = 0; j < 4; ++j) v[k][j] = ((const f32x4*)srcs[k] + lane)[64 * j]; }
            else {
#pragma unroll
                for (int j = 0; j < 4; ++j) v[k][j] = (f32x4){0.f, 0.f, 0.f, 0.f}; } }
#pragma unroll
        for (int k = 0; k < 2; ++k) { const int m = m0 + k * NGW; if (m >= MP) break;
            const int b = m / LP, t = m - b * LP - PADF;
            unsigned long long* o8 = (unsigned long long*)(H + (size_t)m * DM) + lane; float ssum = 0.f;
#pragma unroll
            for (int j = 0; j < 4; ++j) { const f32x4 x = v[k][j]; ssum += (x.x * x.x + x.y * x.y) + (x.z * x.z + x.w * x.w);
                o8[64 * j] = (unsigned long long)cvt_pk_bf16(x.x, x.y) | ((unsigned long long)cvt_pk_bf16(x.z, x.w) << 32); }
            ssum = wave_sum(ssum);
            if (lane < 16) ((float*)(a.ws + WS_SSQH) + (size_t)m * 16)[lane] = (lane == 0) ? ssum : 0.f;
            if (lane < 16) {
                float c = 1.f, sn = 0.f;
                if (t >= 0) { const int p = (t < NMETA) ? t : a.pos[b * SEQ + (t - NMETA)] + NMETA; sincos_d((double)p * c_inv_freq[lane], c, sn); }
                rope[(size_t)m * 32 + lane] = c; rope[(size_t)m * 32 + 16 + lane] = sn;
            }
        }
    }
    { unsigned* ctl = (unsigned*)(a.ws + WS_CTL);
      const int i = gw * 64 + lane; if (i < (int)(CTL_ZERO_BYTES / 4)) ctl[i] = 0u; }
    convert_weights(a, 0, lds, nullptr, wave, lane, 0, CW_FIRST, gw, NGW);
}

__device__ __forceinline__ void phase_pool(const Args& a, int l, int vcu, int NGW, int wv) {
    const int tid = opaque_tid(wv), lane = tid & 63, wave = __builtin_amdgcn_readfirstlane(tid >> 6), gw = vcu * 8 + wave;
    bf16_t* proj = (bf16_t*)(a.ws + WS_PROJ);
    const float* sc = a.pool_scale + (size_t)l * 512 + 8 * lane;
    const f32x4 sc0 = *(const f32x4*)sc, sc1 = *(const f32x4*)(sc + 4);
    const int g = lane >> 4, w = 2 << g;
    constexpr int CR = 17, CPB = (LP + CR - 1) / CR;
    for (int ch = gw; ch < BATCH * CPB; ch += NGW) {
        const int bb = ch / CPB, p0 = (ch - bb * CPB) * CR, r0 = bb * LP + p0, nrows = (LP - p0 < CR) ? LP - p0 : CR;
        if (p0 + CR <= PADF) {
            const u32x4 zz = zero4();
            for (int i = 0; i < nrows; ++i) *(u32x4*)(proj + (size_t)(r0 + i) * PW + C_P1Y + 8 * lane) = zz;
            continue; }
        float S[8];
#pragma unroll
        for (int i = 0; i < 8; ++i) S[i] = 0.f;
        for (int j = 1; j < w; ++j) { const u32x4 uw = *(const u32x4*)(proj + (size_t)(r0 - j) * PW + C_U + 8 * lane); float u[8]; unpack8(uw, u);
#pragma unroll
            for (int i = 0; i < 8; ++i) S[i] += u[i]; }
#pragma unroll 2
        for (int i = 0; i < nrows; ++i) {
            const int m = r0 + i, t = p0 + i - PADF;
            bf16_t* prow = proj + (size_t)m * PW;
            const u32x4 uw = *(const u32x4*)(prow + C_U + 8 * lane); float u[8]; unpack8(uw, u);
            const u32x4 zw = *(const u32x4*)(prow + C_Z + 8 * lane); float z[8]; unpack8(zw, z);
            const u32x4 ow = *(const u32x4*)(proj + (size_t)(m - (w - 1)) * PW + C_U + 8 * lane); float o[8]; unpack8(ow, o);
#pragma unroll
            for (int k = 0; k < 8; ++k) S[k] += u[k];
            f32x4 r0v = (f32x4){0.f, 0.f, 0.f, 0.f}, r1v = r0v;
            if (t >= 0) { const int cnt = (t + 1 < w) ? (t + 1) : w; const float ic = 1.0f / (float)cnt;
#pragma unroll
                for (int k = 0; k < 4; ++k) { r0v[k] = (S[k] * ic - u[k]) * sc0[k] * siluf_(z[k]); r1v[k] = (S[4 + k] * ic - u[4 + k]) * sc1[k] * siluf_(z[4 + k]); } }
            *(u32x4*)(prow + C_P1Y + 8 * lane) = pack8(r0v, r1v);
#pragma unroll
            for (int k = 0; k < 8; ++k) S[k] -= o[k];
        }
    }
}

constexpr int KPITCH = 208, VPITCH = 144, KBUF = 64 * KPITCH, VBUF = 64 * VPITCH;
constexpr float QSCALE = 0.1472444460259031f;
constexpr float MASKV = -1e30f;
__device__ __forceinline__ int kvmap(int r, int hi) { return 8 * hi + r + ((r >= 8) ? 8 : 0); }

__device__ __forceinline__ void attn_unit(const Args& a, int l, int b, int h, int R0, bool special, LAS unsigned char* lds, float kb, int wv) {
    const int tid = opaque_tid(wv), lane = tid & 63, wave = __builtin_amdgcn_readfirstlane(tid >> 6), r32 = lane & 31, hi = lane >> 5;
    const bf16_t* qraw = (const bf16_t*)(a.ws + WS_QRAW); const bf16_t* Kb = (const bf16_t*)(a.ws + WS_H); const bf16_t* Vb = (const bf16_t*)(a.ws + WS_V);
    const float* rope = (const float*)(a.ws + WS_ROPE); bf16_t* proj = (bf16_t*)(a.ws + WS_PROJ);
    const float* gq = a.qn_gain + (size_t)l * 96;
    const int qp = R0 + 32 * wave + r32;
    const int mq = b * LP + qp;
    const int TL = special ? 1 : (R0 + 255) / 64;
    const int qmin = R0 + 32 * wave;
    const int tw = (qmin + 31) / 64 < TL ? (qmin + 31) / 64 : TL;
    const bf16_t* Kh = Kb + (size_t)(b * NH + h) * LP * 96;
    LAS unsigned char* KB0 = lds; LAS unsigned char* VB0 = lds + 4 * KBUF;
    int kofs[2], vofs[2];
#pragma unroll
    for (int i = 0; i < 2; ++i) { const int ck = (wave + 8 * i) * 64 + lane, rk = ck / 13, qk = ck - rk * 13; kofs[i] = rk * 96 + (qk < 12 ? qk : 11) * 8;
        const int cv = (i == 0 ? wave : 8) * 64 + lane, rv = cv / 9, qv = cv - rv * 9; vofs[i] = rv * MP + (qv < 8 ? qv : 7) * 8; }
    const bf16_t* Vh = Vb + (size_t)(h * 64) * MP + (size_t)b * LP;
    const int nis = 2 + (wave < 5 ? 1 : 0) + (wave == 0 ? 1 : 0);
#define ATT_DMAK(t) do { const bf16_t* kt = Kh + (size_t)(t) * 64 * 96; LAS unsigned char* kb = KB0 + ((t) & 3) * KBUF; \
        __builtin_amdgcn_global_load_lds((const unsigned*)(kt + kofs[0]), (LAS unsigned*)(kb + wave * 1024), 16, 0, 0); \
        if (wave < 5) __builtin_amdgcn_global_load_lds((const unsigned*)(kt + kofs[1]), (LAS unsigned*)(kb + (wave + 8) * 1024), 16, 0, 0); } while (0)
#define ATT_DMAV(t) do { const bf16_t* vt = Vh + (t) * 64; LAS unsigned char* vb = VB0 + ((t) % 3) * VBUF; \
        __builtin_amdgcn_global_load_lds((const unsigned*)(vt + vofs[0]), (LAS unsigned*)(vb + wave * 1024), 16, 0, 0); \
        if (wave == 0) __builtin_amdgcn_global_load_lds((const unsigned*)(vt + vofs[1]), (LAS unsigned*)(vb + 8 * 1024), 16, 0, 0); } while (0)
    LAS unsigned char* QST = lds + 81920 + wave * 6144;
    LAS unsigned char* RST = (wave < 3) ? lds + wave * 4096 : (wave < 6) ? lds + 3 * KBUF + (wave - 3) * 4096 : lds + 4 * KBUF + (wave - 6) * 4096;
    { const int mq0 = b * LP + R0 + 32 * wave;
#pragma unroll
      for (int j = 0; j < 6; ++j) { const int c = j * 64 + lane, row = c / 12, piece = c - row * 12;
          __builtin_amdgcn_global_load_lds((const unsigned*)(qraw + (size_t)(mq0 + row) * 768 + h * 96 + piece * 8), (LAS unsigned*)(QST + j * 1024), 16, 0, 0); }
#pragma unroll
      for (int j = 0; j < 4; ++j)
          __builtin_amdgcn_global_load_lds((const unsigned*)(rope + (size_t)mq0 * 32 + (j * 64 + lane) * 4), (LAS unsigned*)(RST + j * 1024), 16, 0, 0); }
    ATT_DMAK(1); ATT_DMAV(1); ATT_DMAK(2);
    if (wave == 0) asm volatile("s_waitcnt vmcnt(6)" ::: "memory"); else if (wave < 5) asm volatile("s_waitcnt vmcnt(5)" ::: "memory"); else asm volatile("s_waitcnt vmcnt(3)" ::: "memory");
    bf16x8 qr[6]; float qnorm = 0.f;
    {
        float qf[6][8]; float ss = 0.f;
        const LAS unsigned char* qs = QST + r32 * 192 + hi * 16;
#pragma unroll
        for (int d0 = 0; d0 < 6; ++d0) { const u32x4 w = *(const LAS u32x4*)(qs + 32 * d0); unpack8(w, qf[d0]);
#pragma unroll
            for (int i = 0; i < 8; ++i) ss += qf[d0][i] * qf[d0][i]; }
        ss += xor32f(ss);
        const float inv = __builtin_amdgcn_rsqf(ss * (1.f / 96.f) + EPS);
#pragma unroll
        for (int d0 = 0; d0 < 6; ++d0) { const f32x4 g0 = *(const f32x4*)(gq + 16 * d0 + 8 * hi), g1 = *(const f32x4*)(gq + 16 * d0 + 8 * hi + 4);
#pragma unroll
            for (int i = 0; i < 4; ++i) { qf[d0][i] *= inv * g0[i]; qf[d0][4 + i] *= inv * g1[i]; } }
        const LAS unsigned char* cs = RST + r32 * 128 + hi * 32;
        const f32x4 c0 = *(const LAS f32x4*)(cs), c1 = *(const LAS f32x4*)(cs + 16), s0 = *(const LAS f32x4*)(cs + 64), s1 = *(const LAS f32x4*)(cs + 80);
#pragma unroll
        for (int i = 0; i < 8; ++i) { const float c = (i < 4) ? c0[i & 3] : c1[i & 3], s = (i < 4) ? s0[i & 3] : s1[i & 3]; const float x1 = qf[4][i], x2 = qf[5][i];
            qf[4][i] = x1 * c - x2 * s; qf[5][i] = x2 * c + x1 * s; }
        { float q2 = 0.f;
#pragma unroll
          for (int d0 = 0; d0 < 6; ++d0)
#pragma unroll
              for (int i = 0; i < 8; ++i) q2 += qf[d0][i] * qf[d0][i];
          q2 += xor32f(q2); qnorm = __builtin_amdgcn_sqrtf(q2) * QSCALE; }
#pragma unroll
        for (int d0 = 0; d0 < 6; ++d0) { u32x4 w; w.x = cvt_pk_bf16(qf[d0][0] * QSCALE, qf[d0][1] * QSCALE); w.y = cvt_pk_bf16(qf[d0][2] * QSCALE, qf[d0][3] * QSCALE);
            w.z = cvt_pk_bf16(qf[d0][4] * QSCALE, qf[d0][5] * QSCALE); w.w = cvt_pk_bf16(qf[d0][6] * QSCALE, qf[d0][7] * QSCALE); qr[d0] = __builtin_bit_cast(bf16x8, w); }
    }
    asm volatile("s_waitcnt vmcnt(0) lgkmcnt(0)" ::: "memory"); __builtin_amdgcn_s_barrier(); asm volatile("" ::: "memory");
    ATT_DMAK(3); ATT_DMAV(2);
    const int krow = kvmap((r32 & 3) + 4 * (r32 >> 3), (r32 >> 2) & 1);
    const int koff = krow * KPITCH + 16 * hi, voff = r32 * VPITCH + 16 * hi;
#define ATT_QK(P0, P1, t, C) do { const LAS unsigned char* kb = KB0 + ((t) & 3) * KBUF + koff; P0 = C; P1 = C; \
        _Pragma("unroll") for (int d0 = 0; d0 < 6; ++d0) { const bf16x8 ka = *(const LAS bf16x8*)(kb + 32 * d0), kc = *(const LAS bf16x8*)(kb + 32 * KPITCH + 32 * d0); \
            P0 = __builtin_amdgcn_mfma_f32_32x32x16_bf16(ka, qr[d0], P0, 0, 0, 0); P1 = __builtin_amdgcn_mfma_f32_32x32x16_bf16(kc, qr[d0], P1, 0, 0, 0); } } while (0)
#define ATT_MASK(P0, P1, t, PADCHK) do { _Pragma("unroll") for (int r = 0; r < 16; ++r) { const int kv = 64 * (t) + kvmap(r, hi); \
        if (!(kv <= qp && (!(PADCHK) || kv >= PADF))) P0[r] = MASKV; if (!(kv + 32 <= qp && (!(PADCHK) || kv + 32 >= PADF))) P1[r] = MASKV; } } while (0)
#define ATT_ROWMAX(P0, P1, RM) do { float a_ = fmaxf(fmaxf(P0[0], P0[1]), P1[0]), b_ = fmaxf(fmaxf(P0[2], P0[3]), P1[1]); a_ = fmaxf(fmaxf(a_, P1[2]), P1[3]); \
        _Pragma("unroll") for (int r = 4; r < 16; r += 4) { a_ = fmaxf(fmaxf(a_, P0[r]), P0[r + 1]); b_ = fmaxf(fmaxf(b_, P0[r + 2]), P0[r + 3]); a_ = fmaxf(fmaxf(a_, P1[r]), P1[r + 1]); b_ = fmaxf(fmaxf(b_, P1[r + 2]), P1[r + 3]); } \
        RM = fmaxf(a_, b_); RM = fmaxf(RM, xor32f(RM)); } while (0)
    const bool fixed = kb > 0.f;
    float mref = fixed ? kb * qnorm : 0.f, lsum = 0.f; f32x16 o0 = {}, o1 = {}, pc0 = {}, pc1 = {}, negm;
#pragma unroll
    for (int r = 0; r < 16; ++r) negm[r] = -mref;
    if (tw >= 1) {
        ATT_QK(pc0, pc1, 1, negm);
        ATT_MASK(pc0, pc1, 1, true);
        if (!fixed) {
            float rm; ATT_ROWMAX(pc0, pc1, rm);
            mref = (rm < -1e29f) ? 0.f : rm;
#pragma unroll
            for (int r = 0; r < 16; ++r) { pc0[r] -= mref; pc1[r] -= mref; negm[r] = -mref; }
        }
    }
#define ATT_EXPP(pc0, pc1) do { float ps = 0.f; \
        _Pragma("unroll") for (int r = 0; r < 16; ++r) { pc0[r] = __builtin_amdgcn_exp2f(pc0[r]); pc1[r] = __builtin_amdgcn_exp2f(pc1[r]); ps += pc0[r] + pc1[r]; } \
        lsum += ps; \
        { u32x4 w; w.x = cvtpk_s(pc0[0], pc0[1]); w.y = cvtpk_s(pc0[2], pc0[3]); w.z = cvtpk_s(pc0[4], pc0[5]); w.w = cvtpk_s(pc0[6], pc0[7]); pa[0] = __builtin_bit_cast(bf16x8, w); \
          w.x = cvtpk_s(pc0[8], pc0[9]); w.y = cvtpk_s(pc0[10], pc0[11]); w.z = cvtpk_s(pc0[12], pc0[13]); w.w = cvtpk_s(pc0[14], pc0[15]); pa[1] = __builtin_bit_cast(bf16x8, w); \
          w.x = cvtpk_s(pc1[0], pc1[1]); w.y = cvtpk_s(pc1[2], pc1[3]); w.z = cvtpk_s(pc1[4], pc1[5]); w.w = cvtpk_s(pc1[6], pc1[7]); pa[2] = __builtin_bit_cast(bf16x8, w); \
          w.x = cvtpk_s(pc1[8], pc1[9]); w.y = cvtpk_s(pc1[10], pc1[11]); w.z = cvtpk_s(pc1[12], pc1[13]); w.w = cvtpk_s(pc1[14], pc1[15]); pa[3] = __builtin_bit_cast(bf16x8, w); } } while (0)
#define ATT_EXP() ATT_EXPP(pc0, pc1)
#define ATT_LDV(t) do { const LAS unsigned char* vb = VB0 + ((t) % 3) * VBUF + voff; \
        _Pragma("unroll") for (int k = 0; k < 4; ++k) { vf[2 * k] = *(const LAS bf16x8*)(vb + 32 * k); vf[2 * k + 1] = *(const LAS bf16x8*)(vb + 32 * VPITCH + 32 * k); } } while (0)
#define ATT_PV() do { _Pragma("unroll") for (int k = 0; k < 4; ++k) { o0 = __builtin_amdgcn_mfma_f32_32x32x16_bf16(vf[2 * k], pa[k], o0, 0, 0, 0); o1 = __builtin_amdgcn_mfma_f32_32x32x16_bf16(vf[2 * k + 1], pa[k], o1, 0, 0, 0); } } while (0)
    if (wave >= 4) __builtin_amdgcn_s_setprio(1);
#define ATT_ISSUE(t) do { if ((t) + 3 <= TL) ATT_DMAK((t) + 3); if ((t) + 2 <= TL) ATT_DMAV((t) + 2); } while (0)
#define ATT_SYNC(t) do { if ((t) + 3 <= TL) { if (nis == 4) asm volatile("s_waitcnt vmcnt(4)" ::: "memory"); else if (nis == 3) asm volatile("s_waitcnt vmcnt(3)" ::: "memory"); else asm volatile("s_waitcnt vmcnt(2)" ::: "memory"); } \
        else asm volatile("s_waitcnt vmcnt(0)" ::: "memory"); \
        LDS_WAIT(); __builtin_amdgcn_s_barrier(); asm volatile("" ::: "memory"); } while (0)
#define ATT_BODY(t, C0, C1, N0, N1) do { ATT_ISSUE(t); \
        bf16x8 vf[8], pa[4]; \
        { const LAS unsigned char* kb_ = KB0 + (((t) + 1) & 3) * KBUF + koff; bf16x8 kf[6]; \
          _Pragma("unroll") for (int d0 = 0; d0 < 3; ++d0) { kf[2 * d0] = *(const LAS bf16x8*)(kb_ + 32 * d0); kf[2 * d0 + 1] = *(const LAS bf16x8*)(kb_ + 32 * KPITCH + 32 * d0); } \
          N0 = __builtin_amdgcn_mfma_f32_32x32x16_bf16(kf[0], qr[0], negm, 0, 0, 0); N1 = __builtin_amdgcn_mfma_f32_32x32x16_bf16(kf[1], qr[0], negm, 0, 0, 0); \
          _Pragma("unroll") for (int d0 = 1; d0 < 3; ++d0) { N0 = __builtin_amdgcn_mfma_f32_32x32x16_bf16(kf[2 * d0], qr[d0], N0, 0, 0, 0); N1 = __builtin_amdgcn_mfma_f32_32x32x16_bf16(kf[2 * d0 + 1], qr[d0], N1, 0, 0, 0); } \
          __builtin_amdgcn_sched_barrier(0); \
          _Pragma("unroll") for (int d0 = 3; d0 < 6; ++d0) { kf[2 * (d0 - 3)] = *(const LAS bf16x8*)(kb_ + 32 * d0); kf[2 * (d0 - 3) + 1] = *(const LAS bf16x8*)(kb_ + 32 * KPITCH + 32 * d0); } \
          _Pragma("unroll") for (int d0 = 3; d0 < 6; ++d0) { N0 = __builtin_amdgcn_mfma_f32_32x32x16_bf16(kf[2 * (d0 - 3)], qr[d0], N0, 0, 0, 0); N1 = __builtin_amdgcn_mfma_f32_32x32x16_bf16(kf[2 * (d0 - 3) + 1], qr[d0], N1, 0, 0, 0); } } \
        ATT_LDV(t); ATT_EXPP(C0, C1); ATT_PV(); \
        if (64 * ((t) + 1) + 63 > qmin) ATT_MASK(N0, N1, (t) + 1, false); \
        if (!fixed) { float rm; ATT_ROWMAX(N0, N1, rm); \
            if (__any(rm > 8.f)) { const float d = (rm > 8.f) ? rm : 0.f; const float f = __builtin_amdgcn_exp2f(-d); mref += d; lsum *= f; \
                _Pragma("unroll") for (int r = 0; r < 16; ++r) { N0[r] -= d; N1[r] -= d; negm[r] -= d; o0[r] *= f; o1[r] *= f; } } } \
        ATT_SYNC(t); } while (0)
#define ATT_TAIL(t, C0, C1) do { ATT_ISSUE(t); bf16x8 vf[8], pa[4]; ATT_LDV(t); ATT_EXPP(C0, C1); ATT_PV(); ATT_SYNC(t); } while (0)
    {
        f32x16 pb0, pb1; int t = 1;
        for (; t + 1 < tw; t += 2) { ATT_BODY(t, pc0, pc1, pb0, pb1); ATT_BODY(t + 1, pb0, pb1, pc0, pc1); }
        if (t < tw) { ATT_BODY(t, pc0, pc1, pb0, pb1); ++t; ATT_TAIL(t, pb0, pb1); ++t; }
        else if (t == tw) { ATT_TAIL(t, pc0, pc1); ++t; }
        for (; t <= TL; ++t) { ATT_ISSUE(t); ATT_SYNC(t); }
    }
    __builtin_amdgcn_s_setprio(0);
#undef ATT_ISSUE
#undef ATT_SYNC
#undef ATT_BODY
#undef ATT_TAIL
#undef ATT_EXPP
#undef ATT_EXP
#undef ATT_LDV
#undef ATT_PV
#undef ATT_DMAK
#undef ATT_DMAV
#undef ATT_QK
#undef ATT_MASK
#undef ATT_ROWMAX
    lsum += xor32f(lsum);
    const float il = (lsum > 0.f) ? 1.0f / lsum : 0.f;
    if (!(special && wave >= 4)) {
        bf16_t* prow = proj + (size_t)mq * PW + h * 64 + (hi ? 8 : 0);
#pragma unroll
        for (int db = 0; db < 2; ++db)
#pragma unroll
            for (int gp = 0; gp < 2; ++gp) {
                const f32x16& o = db ? o1 : o0;
                float v[8];
#pragma unroll
                for (int i = 0; i < 4; ++i) {
                    const auto rr = __builtin_amdgcn_permlane32_swap(__float_as_uint(o[8 * gp + i]), __float_as_uint(o[8 * gp + 4 + i]), false, false);
                    v[i] = __uint_as_float(rr[0]); v[4 + i] = __uint_as_float(rr[1]); }
                const int col = 32 * db + 16 * gp;
                const u32x4 zw = *(const u32x4*)(prow + C_ZM + col); float z[8]; unpack8(zw, z);
                f32x4 r0, r1;
#pragma unroll
                for (int i = 0; i < 4; ++i) { r0[i] = v[i] * il * siluf_(z[i]); r1[i] = v[4 + i] * il * siluf_(z[4 + i]); }
                *(u32x4*)(prow + C_OZ + col) = pack8(r0, r1);
            }
    }
}
__device__ __forceinline__ void phase_attn(const Args& a, int l, LAS unsigned char* lds, int vcu, int G, int wv) {
    float kb;
    { const float* gq = a.qn_gain + (size_t)l * 96; const float* gk = a.kn_gain + (size_t)l * 96;
      float mq = 0.f, mk = 0.f;
      for (int i = 0; i < 96; ++i) { mq = fmaxf(mq, fabsf(gq[i])); mk = fmaxf(mk, fabsf(gk[i])); }
      kb = 1.01f * 9.7979590f * mk;
      const float hi = kb * 9.7979590f * mq * QSCALE;
      if (!(hi < 48.f)) kb = -1.f; }
    const int sp0 = (G == 256) ? ((vcu >= 33 && vcu < 64) ? vcu - 33 : (vcu == 65 ? 31 : -1)) : (vcu < 32 ? vcu : -1);
    const int nmain = (vcu < 512) ? 2 * ((512 - vcu + G - 1) / G) : 0, nspec = (G == 256) ? (sp0 >= 0 ? 1 : 0) : ((vcu < 32) ? (32 - vcu + G - 1) / G : 0);
    for (int j = 0; j < nmain + nspec; ++j) {
        int b, h, R0; bool special;
        if (j < nmain) { const int it = vcu + (j >> 1) * G, bh = it >> 4, s = it & 15; b = bh >> 3; h = bh & 7; R0 = 128 + 256 * ((j & 1) ? 31 - s : s); special = false; }
        else { const int it = (G == 256) ? sp0 : vcu + (j - nmain) * G; b = it >> 3; h = it & 7; R0 = 0; special = true; }
        attn_unit(a, l, b, h, R0, special, lds, kb, wv);
    }
}

constexpr int NPHASE = 1 + 5 * DEPTH;
__global__ void __launch_bounds__(512, 2) trunk_fwd(Args a0) {
    extern __shared__ __attribute__((aligned(16))) unsigned char lds_raw[];
    LAS unsigned char* lds = (LAS unsigned char*)lds_raw;
    const int G = gridDim.x, bx = blockIdx.x;
    const int wv = __builtin_amdgcn_readfirstlane(threadIdx.x >> 6);
    const int vcu = (G % 8 == 0) ? (bx % 8) * (G / 8) + bx / 8 : bx;
    const int NGW = G * 8;
    for (int u = opaque_tid(wv); u < (LDS_BYTES - 131072) / 4; u += 512) ((LAS unsigned*)(lds + 131072))[u] = 0u;
    __syncthreads();
    XcdBarrier bar; bar.bar = (unsigned*)(a0.ws + WS_CTL) + 4096; bar.x = xb_xcc_id(); bar.st = (volatile LAS unsigned*)(lds + MISC_OFF) + 8;
    for (int ph = a0.ph_lo; ph < a0.ph_hi; ++ph) {
        Args a = a0; { size_t off = 0; asm volatile("" : "+s"(off)); a.ws = a0.ws + off; }
        unsigned char* ws = a.ws;
        if (ph == 0) phase_init(a, lds, vcu, NGW, wv);
        else {
            const int l = (ph - 1) / 5, sp = (ph - 1) % 5;
            if (sp == 1) phase_pool(a, l, vcu, NGW, wv);
            else if (sp == 2) phase_attn(a, l, lds, vcu, G, wv);
            for (int j = 0; j < 3; ++j) {
                pg8::Gemm g{nullptr, 0, nullptr, 0, MP, 0, 0, 0};
                EpiAll E{K_IN, ws, a.out, a.kn_gain + (size_t)l * 96, (l == 0) ? a.x : nullptr, a.meta, (l == DEPTH - 1) ? 1 : 0};
                const bf16_t* PROJ = (const bf16_t*)(ws + WS_PROJ); const unsigned char* wb = ws + WS_W;
                if (sp == 0 && j == 0)      { g.A = (const bf16_t*)(ws + WS_H); g.lda = 1024; g.Bt = (const bf16_t*)(wb + W_IN); g.ldb = 1024; g.N = NIN_PAD; g.K = 1024; E.kind = K_IN; }
                else if (sp == 1 && j == 0) { g.A = PROJ + C_CQ; g.lda = PW; g.Bt = (const bf16_t*)(wb + W_Q); g.ldb = 768; g.N = 768; g.K = 768; E.kind = K_Q; }
                else if (sp == 1 && j == 1) { g.A = PROJ + C_CKV; g.lda = PW; g.Bt = (const bf16_t*)(wb + W_KV); g.ldb = 256; g.N = 512; g.K = 256; E.kind = K_KV; }
                else if (sp == 1 && j == 2) { g.A = (const bf16_t*)(wb + W_KV) + 512 * 256; g.lda = 256; g.Bt = PROJ + C_CKV; g.ldb = PW; g.M = 512; g.N = MP; g.K = 256; E.kind = K_VT; }
                else if (sp == 2 && j == 0) { g.A = PROJ + C_P1Y; g.lda = PW; g.Bt = (const bf16_t*)(wb + W_PU); g.ldb = 512; g.N = 1024; g.K = 512; E.kind = K_POOLUP; }
                else if (sp == 3 && j == 0) { g.A = PROJ + C_OZ; g.lda = PW; g.Bt = (const bf16_t*)(wb + W_MU); g.ldb = 512; g.N = 1024; g.K = 512; E.kind = K_MLAUP; }
                else if (sp == 4 && j == 0) { g.A = (const bf16_t*)(ws + WS_QRAW)  ; g.lda = 1024; g.Bt = (const bf16_t*)(wb + W_O) + (size_t)(l & 1) * 1024 * 1024; g.ldb = 1024; g.N = 1024; g.K = 1024; E.kind = K_OUT; }
                else break;
                const int rot = (E.kind == K_KV) ? 134 : (E.kind == K_VT) ? 138 : 0;
                pg8::StaticOrder S; S.init(g.M, g.N, G, (bx + G - rot % G) % G); pg8::gemm_phase(lds, g, S, E, wv);
            }
            if ((sp == 4 && l + 1 < DEPTH) || (sp == 0 && l == 0)) {
                const int tid = opaque_tid(wv), lane = tid & 63, wave = __builtin_amdgcn_readfirstlane(tid >> 6);
                const bool nxt = (sp == 4);
                convert_weights(a, nxt ? l + 1 : 0, lds, (unsigned*)(ws + WS_CTL) + 8192 + 64 * (nxt ? l + 1 : 5), wave, lane, nxt ? 0 : CW_FIRST, CW_NITEMS);
            }
        }
        if (ph + 1 < a0.ph_hi) { if (ph == 0) { __syncthreads(); cg::this_grid().sync(); if (opaque_tid(wv) == 0) (void)xb_add(&bar.bar[XB_XCNT(bar.x)], 1u); } else xcd_barrier(bar, opaque_tid(wv)); }
    }
}

extern "C" void kernel_launch(void* const* d_in, const int* in_sizes, int n_in, void* d_out, int out_size, void* d_ws, size_t ws_size, hipStream_t stream) {
    static int grid = 0;
    if (grid == 0) {
        if (n_in != 16 || out_size != BATCH * SEQ * DM || ws_size < WS_END) { fprintf(stderr, "kernel_launch: unexpected shapes (n_in %d out %d ws %zu)\n", n_in, out_size, ws_size); grid = -1; return; }
        int dev = 0, cus = 0, per_cu = 0;
        hipGetDevice(&dev); hipDeviceGetAttribute(&cus, hipDeviceAttributeMultiprocessorCount, dev);
        if (hipFuncSetAttribute((const void*)trunk_fwd, hipFuncAttributeMaxDynamicSharedMemorySize, LDS_BYTES) != hipSuccess) { fprintf(stderr, "kernel_launch: hipFuncSetAttribute failed\n"); grid = -1; return; }
        if (hipOccupancyMaxActiveBlocksPerMultiprocessor(&per_cu, (const void*)trunk_fwd, 512, LDS_BYTES) != hipSuccess || per_cu < 1) { fprintf(stderr, "kernel_launch: occupancy query says %d\n", per_cu); per_cu = 1; }
        (void)hipGetLastError();
        grid = cus * 1;
    }
    if (grid < 0) return;
    Args a{};
    a.x = (const float*)d_in[0]; a.pos = (const int*)d_in[1]; a.meta = (const float*)d_in[2]; a.norm_gain = (const float*)d_in[3]; a.w_in = (const float*)d_in[4];
    a.pool_wg = (const float*)d_in[5]; a.pool_scale = (const float*)d_in[6]; a.pool_wu = (const float*)d_in[7]; a.qa_gain = (const float*)d_in[8]; a.kva_gain = (const float*)d_in[9];
    a.w_qb = (const float*)d_in[10]; a.w_kvb = (const float*)d_in[11]; a.qn_gain = (const float*)d_in[12]; a.kn_gain = (const float*)d_in[13]; a.mla_wu = (const float*)d_in[14]; a.w_out = (const float*)d_in[15];
    a.out = (float*)d_out; a.ws = (unsigned char*)d_ws;
#if MK_COOP
    a.ph_lo = 0; a.ph_hi = NPHASE;
    void* args[] = {&a};
    hipError_t e = hipLaunchCooperativeKernel((const void*)trunk_fwd, dim3(grid), dim3(512), args, LDS_BYTES, stream);
    if (e != hipSuccess) fprintf(stderr, "cooperative launch failed: %s (grid %d)\n", hipGetErrorString(e), grid);
#else
    for (int ph = 0; ph < NPHASE; ++ph) { a.ph_lo = ph; a.ph_hi = ph + 1; hipLaunchKernelGGL(trunk_fwd, dim3(grid), dim3(512), LDS_BYTES, stream, a); }
#endif
}
```
